# Optimizing an MI355X kernel written in HIP

```python
import jax, jax.numpy as jnp
from jax import lax
import numpy as np

D_MODEL = 1024
BATCH = 16
SEQ = 4096
DEPTH = 1
DEC_BATCH = 8
DEC_SEQ = 64
PAST_LEN = 2048

CHUNK = 64
Q_BLOCK = 128
N_MEM = 256
FOX_HEADS = 8
FOX_HEAD_DIM = 64
FOX_WIDTH = FOX_HEADS * FOX_HEAD_DIM
MLA_HEADS = 8
MLA_NOPE_DIM = 64
MLA_ROPE_DIM = 32
MLA_V_DIM = 64
MLA_WIDTH = MLA_HEADS * MLA_V_DIM
MLA_Q_RANK = 384
MLA_KV_RANK = 256
MIX_WIDTH = FOX_WIDTH + MLA_WIDTH
MEM_HEADS = 4
MEM_HEAD_DIM = 128
MEM_WIDTH = MEM_HEADS * MEM_HEAD_DIM
D_FF = -(-8 * D_MODEL // (3 * 256)) * 256
ROPE_THETA = 10000.0
RMS_EPS = 1e-6
FORGET_BIAS_INIT = 3.0
FOX_SCALE = FOX_HEAD_DIM ** -0.5
MLA_SCALE = (MLA_NOPE_DIM + MLA_ROPE_DIM) ** -0.5
MEM_SCALE = MEM_HEAD_DIM ** -0.5
IN_SPLITS = (FOX_WIDTH, FOX_WIDTH, FOX_WIDTH, FOX_HEADS, MLA_Q_RANK, MLA_KV_RANK, MLA_ROPE_DIM)
IN_WIDTH = 3 * FOX_WIDTH + FOX_HEADS + MLA_Q_RANK + MLA_KV_RANK + MLA_ROPE_DIM

kernel_name = "hybrid_fox_mla_streaming_step"


def rms_norm(x, g):
    xf = x.astype(jnp.float32)
    y = xf * lax.rsqrt(jnp.mean(xf * xf, axis=-1, keepdims=True) + RMS_EPS)
    return (y * g.astype(jnp.float32)).astype(x.dtype)


def rope_tables(pos):
    half = MLA_ROPE_DIM // 2
    inv = ROPE_THETA ** (-jnp.arange(half, dtype=jnp.float32) / half)
    ang = pos.astype(jnp.float32)[:, None] * inv[None, :]
    return jnp.cos(ang), jnp.sin(ang)


def apply_rope(x, cos, sin):
    xf = x.astype(jnp.float32)
    x1, x2 = jnp.split(xf, 2, axis=-1)
    return jnp.concatenate([x1 * cos - x2 * sin, x2 * cos + x1 * sin], axis=-1).astype(x.dtype)


def attend(q, k, v, q_pos, k_pos, scale, unit, q_bias=None, k_bias=None):
    s = jnp.einsum("bqhd,bkhd->bhqk", q, k).astype(jnp.float32) * scale
    if q_bias is not None:
        s = s + jnp.swapaxes(q_bias, 1, 2)[..., :, None] - jnp.swapaxes(k_bias, 1, 2)[..., None, :]
    visible = (k_pos[None, :] // unit) <= (q_pos[:, None] // unit)
    s = jnp.where(visible, s, -jnp.inf)
    p = jax.nn.softmax(s, axis=-1).astype(v.dtype)
    return jnp.einsum("bhqk,bkhd->bqhd", p, v)


def attend_blocks(q, k, v, q_pos, k_pos, scale, unit, q_bias=None, k_bias=None):
    B, T, H, dk = q.shape
    nb = T // Q_BLOCK
    qb = jnp.swapaxes(q.reshape(B, nb, Q_BLOCK, H, dk), 0, 1)
    pb = q_pos.reshape(nb, Q_BLOCK)
    if q_bias is None:
        out = lax.map(lambda a: attend(a[0], k, v, a[1], k_pos, scale, unit), (qb, pb))
    else:
        bb = jnp.swapaxes(q_bias.reshape(B, nb, Q_BLOCK, H), 0, 1)
        out = lax.map(lambda a: attend(a[0], k, v, a[1], k_pos, scale, unit, a[2], k_bias), (qb, pb, bb))
    return jnp.swapaxes(out, 0, 1).reshape(B, T, H, v.shape[-1])


def project_mixers(h, pos, w_in, b_f, g_cq, w_uq, g_ckv):
    B, T, _ = h.shape
    z = h @ w_in
    offs = np.cumsum(IN_SPLITS)[:-1].tolist()
    q_f, k_f, v_f, f_logit, c_q, c_kv, k_r = jnp.split(z, offs, axis=-1)
    fox_q = q_f.reshape(B, T, FOX_HEADS, FOX_HEAD_DIM)
    fox_k = k_f.reshape(B, T, FOX_HEADS, FOX_HEAD_DIM)
    fox_v = v_f.reshape(B, T, FOX_HEADS, FOX_HEAD_DIM)
    logf = jax.nn.log_sigmoid((f_logit + b_f).astype(jnp.float32))
    cos, sin = rope_tables(pos)
    q_m = (rms_norm(c_q, g_cq) @ w_uq).reshape(B, T, MLA_HEADS, MLA_NOPE_DIM + MLA_ROPE_DIM)
    q_nope, q_rope = jnp.split(q_m, [MLA_NOPE_DIM], axis=-1)
    mla_q = jnp.concatenate([q_nope, apply_rope(q_rope, cos[:, None, :], sin[:, None, :])], axis=-1)
    ckv = rms_norm(c_kv, g_ckv)
    kr = apply_rope(k_r, cos, sin)
    return fox_q, fox_k, fox_v, logf, mla_q, ckv, kr


def mla_keys_values(ckv, kr, w_ukv):
    B, S, _ = ckv.shape
    kv = (ckv @ w_ukv).reshape(B, S, MLA_HEADS, MLA_NOPE_DIM + MLA_V_DIM)
    k_nope, v = jnp.split(kv, [MLA_NOPE_DIM], axis=-1)
    k = jnp.concatenate([k_nope, jnp.broadcast_to(kr[:, :, None, :], (B, S, MLA_HEADS, MLA_ROPE_DIM))], axis=-1)
    return k, v


def memory_kv(mem, g_mem_src, w_mk, w_mv):
    B, M, _ = mem.shape
    m = rms_norm(mem, g_mem_src)
    return ((m @ w_mk).reshape(B, M, MEM_HEADS, MEM_HEAD_DIM),
            (m @ w_mv).reshape(B, M, MEM_HEADS, MEM_HEAD_DIM))


def trunk_layer(x, pos, mem_k, mem_v, past, w):
    (g_mix, w_in, b_f, g_cq, w_uq, g_ckv, w_ukv, g_fox_out, g_mla_out, w_o,
     g_mem, w_mq, w_mo, g_ffn, w_gate, w_up, w_down) = w
    B, T, _ = x.shape
    h = rms_norm(x, g_mix)
    fox_q, fox_k, fox_v, logf, mla_q, ckv, kr = project_mixers(h, pos, w_in, b_f, g_cq, w_uq, g_ckv)
    if past is None:
        cum = jnp.cumsum(logf, axis=1)
        fox_o = attend_blocks(fox_q, fox_k, fox_v, pos, pos, FOX_SCALE, 1, cum, cum)
        mk, mv = mla_keys_values(ckv, kr, w_ukv)
        mla_o = attend_blocks(mla_q, mk, mv, pos, pos, MLA_SCALE, CHUNK)
    else:
        c_fk, c_fv, c_lf, c_ckv, c_kr = past
        P = c_fk.shape[1]
        k_pos = jnp.arange(P + T, dtype=jnp.int32)
        cum = jnp.cumsum(jnp.concatenate([c_lf.astype(jnp.float32), logf], axis=1), axis=1)
        fox_o = attend(fox_q, jnp.concatenate([c_fk, fox_k], axis=1), jnp.concatenate([c_fv, fox_v], axis=1),
                       pos, k_pos, FOX_SCALE, 1, cum[:, P:], cum)
        mk, mv = mla_keys_values(jnp.concatenate([c_ckv, ckv], axis=1), jnp.concatenate([c_kr, kr], axis=1), w_ukv)
        mla_o = attend(mla_q, mk, mv, pos, k_pos, MLA_SCALE, CHUNK)
    mixed = jnp.concatenate([rms_norm(fox_o.reshape(B, T, FOX_WIDTH), g_fox_out),
                             rms_norm(mla_o.reshape(B, T, MLA_WIDTH), g_mla_out)], axis=-1)
    x = x + mixed @ w_o
    q = (rms_norm(x, g_mem) @ w_mq).reshape(B, T, MEM_HEADS, MEM_HEAD_DIM)
    s = jnp.einsum("bqhd,bmhd->bhqm", q, mem_k).astype(jnp.float32) * MEM_SCALE
    p = jax.nn.softmax(s, axis=-1).astype(mem_v.dtype)
    o = jnp.einsum("bhqm,bmhd->bqhd", p, mem_v).reshape(B, T, MEM_WIDTH)
    x = x + o @ w_mo
    hf = rms_norm(x, g_ffn)
    x = x + (jax.nn.silu(hf @ w_gate) * (hf @ w_up)) @ w_down
    return x, (fox_k, fox_v, logf, ckv, kr)


def setup_inputs(seed: int = 0) -> dict:
    key = jax.random.key(seed)
    ks = iter(jax.random.split(key, 40))
    f32 = jnp.float32

    def nrm(shape, scale=1.0):
        return jax.random.normal(next(ks), shape, f32) * scale

    def gain(n):
        return 1.0 + nrm((DEPTH, n), 0.02)

    L = DEPTH
    return {
        "x_prompt": nrm((BATCH, SEQ, D_MODEL)),
        "x_sample": nrm((DEC_BATCH, DEC_SEQ, D_MODEL)),
        "mem_prompt": nrm((BATCH, N_MEM, D_MODEL)),
        "cache_fox_k": nrm((L, DEC_BATCH, PAST_LEN, FOX_HEADS, FOX_HEAD_DIM)),
        "cache_fox_v": nrm((L, DEC_BATCH, PAST_LEN, FOX_HEADS, FOX_HEAD_DIM)),
        "cache_fox_logf": jax.nn.log_sigmoid(FORGET_BIAS_INIT + nrm((L, DEC_BATCH, PAST_LEN, FOX_HEADS))),
        "cache_mla_ckv": nrm((L, DEC_BATCH, PAST_LEN, MLA_KV_RANK)),
        "cache_mla_kr": nrm((L, DEC_BATCH, PAST_LEN, MLA_ROPE_DIM)),
        "cache_mem_k": nrm((L, DEC_BATCH, N_MEM, MEM_HEADS, MEM_HEAD_DIM)),
        "cache_mem_v": nrm((L, DEC_BATCH, N_MEM, MEM_HEADS, MEM_HEAD_DIM)),
        "g_mix": gain(D_MODEL),
        "w_in": nrm((L, D_MODEL, IN_WIDTH), D_MODEL ** -0.5),
        "b_f": FORGET_BIAS_INIT + nrm((L, FOX_HEADS), 0.1),
        "g_cq": gain(MLA_Q_RANK),
        "w_uq": nrm((L, MLA_Q_RANK, MLA_HEADS * (MLA_NOPE_DIM + MLA_ROPE_DIM)), MLA_Q_RANK ** -0.5),
        "g_ckv": gain(MLA_KV_RANK),
        "w_ukv": nrm((L, MLA_KV_RANK, MLA_HEADS * (MLA_NOPE_DIM + MLA_V_DIM)), MLA_KV_RANK ** -0.5),
        "g_fox_out": gain(FOX_WIDTH),
        "g_mla_out": gain(MLA_WIDTH),
        "w_o": nrm((L, MIX_WIDTH, D_MODEL), MIX_WIDTH ** -0.5),
        "g_mem_src": gain(D_MODEL),
        "w_mk": nrm((L, D_MODEL, MEM_WIDTH), D_MODEL ** -0.5),
        "w_mv": nrm((L, D_MODEL, MEM_WIDTH), D_MODEL ** -0.5),
        "g_mem": gain(D_MODEL),
        "w_mq": nrm((L, D_MODEL, MEM_WIDTH), D_MODEL ** -0.5),
        "w_mo": nrm((L, MEM_WIDTH, D_MODEL), MEM_WIDTH ** -0.5),
        "g_ffn": gain(D_MODEL),
        "w_gate": nrm((L, D_MODEL, D_FF), D_MODEL ** -0.5),
        "w_up": nrm((L, D_MODEL, D_FF), D_MODEL ** -0.5),
        "w_down": nrm((L, D_FF, D_MODEL), D_FF ** -0.5),
        "g_final": 1.0 + nrm((D_MODEL,), 0.02),
    }


def reference(x_prompt, x_sample, mem_prompt, cache_fox_k, cache_fox_v, cache_fox_logf,
              cache_mla_ckv, cache_mla_kr, cache_mem_k, cache_mem_v,
              g_mix, w_in, b_f, g_cq, w_uq, g_ckv, w_ukv, g_fox_out, g_mla_out, w_o,
              g_mem_src, w_mk, w_mv, g_mem, w_mq, w_mo, g_ffn, w_gate, w_up, w_down, g_final):
    t_p = x_prompt.shape[1]
    t_s = x_sample.shape[1]
    past_len = cache_fox_k.shape[2]
    pos_p = jnp.arange(t_p, dtype=jnp.int32)
    pos_s = past_len + jnp.arange(t_s, dtype=jnp.int32)
    xp, xs = x_prompt, x_sample
    rows_p, rows_s, mem_p = [], [], []
    for l in range(DEPTH):
        w = (g_mix[l], w_in[l], b_f[l], g_cq[l], w_uq[l], g_ckv[l], w_ukv[l], g_fox_out[l], g_mla_out[l], w_o[l],
             g_mem[l], w_mq[l], w_mo[l], g_ffn[l], w_gate[l], w_up[l], w_down[l])
        mk_p, mv_p = memory_kv(mem_prompt, g_mem_src[l], w_mk[l], w_mv[l])
        xp, rp = trunk_layer(xp, pos_p, mk_p, mv_p, None, w)
        past = (cache_fox_k[l], cache_fox_v[l], cache_fox_logf[l], cache_mla_ckv[l], cache_mla_kr[l])
        xs, rs = trunk_layer(xs, pos_s, cache_mem_k[l], cache_mem_v[l], past, w)
        rows_p.append(rp)
        rows_s.append(rs)
        mem_p.append((mk_p, mv_p))
    y_prompt = rms_norm(xp, g_final)
    y_sample = rms_norm(xs, g_final)
    p_fox_k = jnp.stack([r[0] for r in rows_p])
    p_fox_v = jnp.stack([r[1] for r in rows_p])
    p_fox_logf = jnp.stack([r[2] for r in rows_p])
    p_mla_ckv = jnp.stack([r[3] for r in rows_p])
    p_mla_kr = jnp.stack([r[4] for r in rows_p])
    p_mem_k = jnp.stack([m[0] for m in mem_p])
    p_mem_v = jnp.stack([m[1] for m in mem_p])
    s_fox_k = jnp.stack([r[0] for r in rows_s])
    s_fox_v = jnp.stack([r[1] for r in rows_s])
    s_fox_logf = jnp.stack([r[2] for r in rows_s])
    s_mla_ckv = jnp.stack([r[3] for r in rows_s])
    s_mla_kr = jnp.stack([r[4] for r in rows_s])
    return (y_prompt, y_sample, p_fox_k, p_fox_v, p_fox_logf, p_mla_ckv, p_mla_kr, p_mem_k, p_mem_v,
            s_fox_k, s_fox_v, s_fox_logf, s_mla_ckv, s_mla_kr)
```

```cpp
#include <hip/hip_runtime.h>
#include <hip/hip_cooperative_groups.h>
#include <cstdio>
#include <cstdint>
namespace cg = cooperative_groups;
namespace pg8 {
#define PG8_LAS __attribute__((address_space(3)))
typedef unsigned short bf16_t;
typedef short bf16x8 __attribute__((ext_vector_type(8)));
typedef float f32x4 __attribute__((ext_vector_type(4)));
typedef unsigned u32x4 __attribute__((ext_vector_type(4)));
constexpr int BM = 256, BK = 64, HALF = 128, HTB = HALF * BK * 2  , STAGE_BYTES = 8 * HTB, NXCD = 8, WGM = 8;

__host__ __device__ __forceinline__ int lds_byte(int r, int c) { const int st = (r >> 4) * 2 + (c >> 5), rr = r & 15, cc = c & 31, ob = rr * 64 + cc * 2; return st * 1024 + (ob ^ (((ob >> 9) & 1) << 5)); }
__host__ __device__ __forceinline__ void stage_rc(int b, int& R, int& C) { const int st = b / 1024, sb = b % 1024, swz = sb ^ (((sb >> 9) & 1) << 5); R = (st >> 1) * 16 + swz / 64; C = (st & 1) * 32 + (swz % 64) / 2; }
__host__ __device__ __forceinline__ int perm32(int rho) { const int n = rho >> 4, i = rho & 15; return 8 * (i >> 2) + 4 * n + (i & 3); }

struct Unit { int pm, pn; };
struct Gemm { const bf16_t* A; const bf16_t* Bt; int M, N, K; };

struct StaticOrder {
    int nM, nN, nwg, G, c;
    __host__ __device__ void init(int M, int N, int G_, int c_) { nM = M / BM; nN = N / BM; nwg = nM * nN; G = G_; c = c_; }
    __host__ __device__ bool next(int i, Unit& u) const {
        const long L = (long)i * G + c; if (L >= nwg) return false;
        int wgid = (int)L; { const int q = nwg / NXCD, r = nwg % NXCD, xcd = wgid % NXCD, off = wgid / NXCD; wgid = (xcd < r ? xcd * (q + 1) : r * (q + 1) + (xcd - r) * q) + off; }
        const int nig = WGM * nN, gid = wgid / nig, fm = gid * WGM, gsz = (nM - fm) < WGM ? (nM - fm) : WGM;
        u.pm = fm + ((wgid % nig) % gsz); u.pn = (wgid % nig) / gsz; return true;
    }
    __device__ __forceinline__ void a_ready(const Unit&) const {}
    __device__ __forceinline__ void done(const Unit&) const {}
};

template <class Epi, class Sched, bool ALIGN_EPI = false, bool SP2 = false>
__device__ __forceinline__ void gemm_phase(PG8_LAS unsigned char* lds, const Gemm g, const Sched& S, const Epi& E) {
    int tid_ = threadIdx.x; asm volatile("" : "+v"(tid_)); const int tid = tid_, wid = __builtin_amdgcn_readfirstlane(tid >> 6), lane = tid & 63, wr = wid >> 2, wc = wid & 3, fr = lane & 15, fq = lane >> 4;
    const int K = g.K, nt = K / BK;
    unsigned voffA[2], voffB[2];
#pragma unroll
    for (int i = 0; i < 2; ++i) { int R, C; stage_rc(tid * 16 + i * 8192, R, C); const int Rb = Epi::PERM ? ((R & ~31) + perm32(R & 31)) : R;
        voffA[i] = (unsigned)(R * K + C) * 2u; voffB[i] = (unsigned)(Rb * K + C) * 2u; }
    const size_t kstep = (size_t)(BK * 2);
    const size_t hstep = (size_t)HALF * K * 2;
    const size_t tstep = 2 * hstep;
    const unsigned ldsw = (unsigned)wid * 1024u;
    const int aoff = lds_byte(wr * 64 + fr, fq * 8), boff = lds_byte(wc * 32 + fr, fq * 8);
#define PG8_SA(b, h) (((b) * 2 + (h)) * HTB)
#define PG8_SB(b, h) ((4 + (b) * 2 + (h)) * HTB)
#define PG8_STAGE(bufoff, gbase, voff) do { _Pragma("unroll") for (int _i = 0; _i < 2; ++_i) \
        __builtin_amdgcn_global_load_lds((const unsigned*)((const char*)(gbase) + (voff)[_i]), (PG8_LAS unsigned*)(lds + (bufoff) + ldsw + _i * 8192), 16, 0, 0); } while (0)
#define PG8_LDA(dst, b, h) do { _Pragma("unroll") for (int m = 0; m < 4; ++m) _Pragma("unroll") for (int k = 0; k < 2; ++k) dst[m][k] = *(const PG8_LAS bf16x8*)(lds + PG8_SA(b, h) + aoff + m * 2048 + k * 1024); } while (0)
#define PG8_LDB(dst, b, h) do { _Pragma("unroll") for (int n = 0; n < 2; ++n) _Pragma("unroll") for (int k = 0; k < 2; ++k) dst[n][k] = *(const PG8_LAS bf16x8*)(lds + PG8_SB(b, h) + boff + n * 2048 + k * 1024); } while (0)
#define PG8_MMA(ai, bj, At, Bt) do { __builtin_amdgcn_s_setprio(1); _Pragma("unroll") for (int m = 0; m < 4; ++m) _Pragma("unroll") for (int n = 0; n < 2; ++n) _Pragma("unroll") for (int k = 0; k < 2; ++k) \
        acc[ai][bj][m][n] = __builtin_amdgcn_mfma_f32_16x16x32_bf16(Bt[n][k], At[m][k], acc[ai][bj][m][n], 0, 0, 0); __builtin_amdgcn_s_setprio(0); } while (0)
#define PG8_WAIT_V(n) asm volatile("s_waitcnt vmcnt(" #n ")" ::: "memory")
#define PG8_WAIT_L(n) asm volatile("s_waitcnt lgkmcnt(" #n ")" ::: "memory")
#define PG8_BAR __builtin_amdgcn_s_barrier()
#define PG8_SCHED __builtin_amdgcn_sched_barrier(0)
    Unit cur, nxt; int ui = 0;
    if (!S.next(0, cur)) return;
    f32x4 acc[2][2][4][2];
#pragma unroll
    for (int a = 0; a < 2; ++a)
#pragma unroll
        for (int b = 0; b < 2; ++b)
#pragma unroll
            for (int m = 0; m < 4; ++m)
#pragma unroll
                for (int n = 0; n < 2; ++n) acc[a][b][m][n] = (f32x4){0.f, 0.f, 0.f, 0.f};
    bf16x8 At[4][2], B0[2][2], B1[2][2];
    const char* cA = (const char*)g.A + (size_t)cur.pm * tstep; const char* cB = (const char*)g.Bt + (size_t)cur.pn * tstep;
    S.a_ready(cur);
    if constexpr (SP2) {
        PG8_STAGE(PG8_SB(0, 0), cB, voffB); PG8_STAGE(PG8_SB(0, 1), cB + hstep, voffB); PG8_STAGE(PG8_SA(0, 0), cA, voffA); PG8_STAGE(PG8_SA(0, 1), cA + hstep, voffA);
        if (wr == 1) PG8_BAR;
        PG8_WAIT_V(2); PG8_BAR;
        PG8_STAGE(PG8_SB(1, 0), cB + kstep, voffB); PG8_STAGE(PG8_SA(1, 0), cA + kstep, voffA); PG8_STAGE(PG8_SB(1, 1), cB + hstep + kstep, voffB);
        PG8_WAIT_V(6); PG8_BAR;
    } else {
        PG8_STAGE(PG8_SB(0, 0), cB, voffB); PG8_STAGE(PG8_SA(0, 0), cA, voffA); PG8_STAGE(PG8_SB(0, 1), cB + hstep, voffB); PG8_STAGE(PG8_SA(0, 1), cA + hstep, voffA);
        if (wr == 1) PG8_BAR;
        PG8_WAIT_V(4); PG8_BAR;
        PG8_STAGE(PG8_SB(1, 0), cB + kstep, voffB); PG8_STAGE(PG8_SA(1, 0), cA + kstep, voffA); PG8_STAGE(PG8_SB(1, 1), cB + hstep + kstep, voffB);
        PG8_WAIT_V(6); PG8_BAR;
    }
    for (;;) {
        const bool has_next = S.next(ui + 1, nxt);
        const char* nA = has_next ? (const char*)g.A + (size_t)nxt.pm * tstep : cA; const char* nB = has_next ? (const char*)g.Bt + (size_t)nxt.pn * tstep : cB;
        for (int t = 0; t < nt; t += 2) {
            const bool last = (t == nt - 2);
            const char* a1 = cA + (size_t)(t + 1) * kstep;
            const char* a2 = last ? nA : cA + (size_t)(t + 2) * kstep; const char* b2 = last ? nB : cB + (size_t)(t + 2) * kstep;
            const char* a3 = a2 + kstep; const char* b3 = b2 + kstep;
            if (last && has_next) S.a_ready(nxt);
            if constexpr (SP2) {
            PG8_LDB(B0, 0, 0); PG8_LDB(B1, 0, 1); PG8_SCHED; PG8_LDA(At, 0, 0); PG8_STAGE(PG8_SA(1, 1), a1 + hstep, voffA);
            PG8_WAIT_V(8); PG8_WAIT_L(0); PG8_BAR; PG8_MMA(0, 0, At, B0); PG8_MMA(0, 1, At, B1); PG8_BAR; PG8_SCHED;
            PG8_LDA(At, 0, 1); PG8_STAGE(PG8_SB(0, 0), b2, voffB); PG8_STAGE(PG8_SB(0, 1), b2 + hstep, voffB); PG8_STAGE(PG8_SA(0, 0), a2, voffA);
            PG8_WAIT_V(8); PG8_WAIT_L(0); PG8_BAR; PG8_MMA(1, 0, At, B0); PG8_MMA(1, 1, At, B1); PG8_BAR; PG8_SCHED;
            PG8_LDB(B0, 1, 0); PG8_LDB(B1, 1, 1); PG8_SCHED; PG8_LDA(At, 1, 0); PG8_STAGE(PG8_SA(0, 1), a2 + hstep, voffA);
            PG8_WAIT_V(8); PG8_WAIT_L(0); PG8_BAR; PG8_MMA(0, 0, At, B0); PG8_MMA(0, 1, At, B1); PG8_BAR; PG8_SCHED;
            PG8_LDA(At, 1, 1); PG8_STAGE(PG8_SB(1, 0), b3, voffB); PG8_STAGE(PG8_SB(1, 1), b3 + hstep, voffB); PG8_STAGE(PG8_SA(1, 0), a3, voffA);
            PG8_WAIT_V(8); PG8_WAIT_L(0); PG8_BAR; PG8_MMA(1, 0, At, B0); PG8_MMA(1, 1, At, B1); PG8_BAR; PG8_SCHED;
            } else {
            PG8_LDB(B0, 0, 0); PG8_SCHED; PG8_LDA(At, 0, 0); PG8_STAGE(PG8_SA(1, 1), a1 + hstep, voffA);
            PG8_WAIT_L(8); PG8_BAR; PG8_WAIT_L(0); PG8_MMA(0, 0, At, B0); PG8_BAR; PG8_SCHED;
            PG8_LDB(B1, 0, 1); PG8_STAGE(PG8_SB(0, 0), b2, voffB);
            PG8_BAR; PG8_WAIT_L(0); PG8_MMA(0, 1, At, B1); PG8_BAR;
            PG8_LDA(At, 0, 1); PG8_STAGE(PG8_SA(0, 0), a2, voffA);
            PG8_BAR; PG8_WAIT_L(0); PG8_MMA(1, 0, At, B0); PG8_BAR; PG8_SCHED;
            PG8_STAGE(PG8_SB(0, 1), b2 + hstep, voffB);
            PG8_WAIT_V(6); PG8_BAR; PG8_MMA(1, 1, At, B1); PG8_BAR;
            PG8_LDB(B0, 1, 0); PG8_SCHED; PG8_LDA(At, 1, 0); PG8_STAGE(PG8_SA(0, 1), a2 + hstep, voffA);
            PG8_WAIT_L(8); PG8_BAR; PG8_WAIT_L(0); PG8_MMA(0, 0, At, B0); PG8_BAR; PG8_SCHED;
            PG8_LDB(B1, 1, 1); PG8_STAGE(PG8_SB(1, 0), b3, voffB);
            PG8_BAR; PG8_WAIT_L(0); PG8_MMA(0, 1, At, B1); PG8_BAR;
            PG8_LDA(At, 1, 1); PG8_STAGE(PG8_SA(1, 0), a3, voffA);
            PG8_BAR; PG8_WAIT_L(0); PG8_MMA(1, 0, At, B0); PG8_BAR; PG8_SCHED;
            PG8_STAGE(PG8_SB(1, 1), b3 + hstep, voffB);
            PG8_WAIT_V(6); PG8_BAR; PG8_MMA(1, 1, At, B1); PG8_BAR;
            }
        }
        if constexpr (ALIGN_EPI) { if (wr == 0) PG8_BAR; }
        if constexpr (!Epi::AFTER_DRAIN) { E(acc, cur, wr, wc, fr, fq); S.done(cur); }
        if (!has_next) break;
#pragma unroll
        for (int a = 0; a < 2; ++a)
#pragma unroll
            for (int b = 0; b < 2; ++b)
#pragma unroll
                for (int m = 0; m < 4; ++m)
#pragma unroll
                    for (int n = 0; n < 2; ++n) acc[a][b][m][n] = (f32x4){0.f, 0.f, 0.f, 0.f};
        cur = nxt; cA = nA; cB = nB; ++ui;
        if constexpr (ALIGN_EPI) { if (wr == 1) PG8_BAR; }
    }
    PG8_WAIT_V(0);
    if constexpr (!ALIGN_EPI) { if (wr == 0) PG8_BAR; }
    PG8_BAR;
    if constexpr (Epi::AFTER_DRAIN) { E.fused(acc, cur, wr, wc, fr, fq, lds, wid, lane); S.done(cur); }
#undef PG8_SA
#undef PG8_SB
#undef PG8_STAGE
#undef PG8_LDA
#undef PG8_LDB
#undef PG8_MMA
#undef PG8_WAIT_V
#undef PG8_WAIT_L
#undef PG8_BAR
#undef PG8_SCHED
}
}

#define LAS __attribute__((address_space(3)))
typedef unsigned short bf16_t;
typedef short bf16x8 __attribute__((ext_vector_type(8)));
typedef short s16x4 __attribute__((ext_vector_type(4)));
typedef float f32x4 __attribute__((ext_vector_type(4)));
typedef float f32x2 __attribute__((ext_vector_type(2)));
typedef float f32x16 __attribute__((ext_vector_type(16)));
typedef unsigned u32x4 __attribute__((ext_vector_type(4)));
typedef unsigned u32x2 __attribute__((ext_vector_type(2)));
typedef __bf16 bf16x2_t __attribute__((ext_vector_type(2)));

constexpr int MP = 65536, MS = 512, MT = MP + MS, PAST = 2048, SKV = 2112, KVR = MP + 8 * SKV;
constexpr float EPS = 1e-6f, LOG2E = 1.4426950408889634f;
constexpr float QS_FOX = 0.125f * LOG2E, QS_MLA = 0.10206207261596575f * LOG2E, QS_MEM = 0.08838834764831845f * LOG2E;
constexpr int NTHR = 512;

constexpr size_t OFF_Y = 0;
constexpr size_t OFF_P_FOX_K = (size_t)MT * 1024;
constexpr size_t OFF_P_FOX_V = OFF_P_FOX_K + (size_t)MP * 512;
constexpr size_t OFF_P_LOGF = OFF_P_FOX_V + (size_t)MP * 512;
constexpr size_t OFF_P_CKV = OFF_P_LOGF + (size_t)MP * 8;
constexpr size_t OFF_P_KR = OFF_P_CKV + (size_t)MP * 256;
constexpr size_t OFF_P_MEM_K = OFF_P_KR + (size_t)MP * 32;
constexpr size_t OFF_P_MEM_V = OFF_P_MEM_K + (size_t)4096 * 512;
constexpr size_t OFF_S_FOX_K = OFF_P_MEM_V + (size_t)4096 * 512;
constexpr size_t OFF_S_FOX_V = OFF_S_FOX_K + (size_t)MS * 512;
constexpr size_t OFF_S_LOGF = OFF_S_FOX_V + (size_t)MS * 512;
constexpr size_t OFF_S_CKV = OFF_S_LOGF + (size_t)MS * 8;
constexpr size_t OFF_S_KR = OFF_S_CKV + (size_t)MS * 256;
constexpr size_t OUT_TOTAL = OFF_S_KR + (size_t)MS * 32;
static_assert(OUT_TOTAL == 159010816ull, "d_out map");

constexpr size_t MiB = 1u << 20;
constexpr size_t WS_W_IN = 0, WS_W_UQ = 5 * MiB, WS_W_UKV = 6 * MiB, WS_W_O = 7 * MiB, WS_W_MKV = 9 * MiB, WS_W_MQ = 11 * MiB, WS_W_MO = 12 * MiB,
                 WS_W_GU = 13 * MiB, WS_W_D = 24 * MiB, WS_ROPE = 30 * MiB, WS_SSQ = 31 * MiB, WS_CUM = 33 * MiB, WS_MEMK = 36 * MiB, WS_MEMV = 42 * MiB,
                 WS_MN = 48 * MiB, WS_XN = 56 * MiB  , WS_D = 185 * MiB;
constexpr size_t WS_ZS = WS_D, WS_QF = 282 * MiB, WS_KF = 347 * MiB, WS_VF = 428 * MiB, WS_CQR = 509 * MiB, WS_CKVB = 558 * MiB, WS_KRB = 599 * MiB,
                 WS_MQ = 605 * MiB, WS_MKN = 702 * MiB, WS_MV = 783 * MiB, WS_END = 864 * MiB;
constexpr size_t WS_XB = WS_D, WS_CQ = 314 * MiB, WS_CO = 379 * MiB, WS_H = 444 * MiB;
static_assert(WS_H + (size_t)MT * 2816 * 2 <= WS_END, "H overlay");
static_assert(WS_ZS + (size_t)MT * 384 * 4 <= WS_QF && WS_QF + (size_t)MT * 512 * 2 <= WS_KF && WS_KF + (size_t)KVR * 512 * 2 <= WS_VF && WS_VF + (size_t)KVR * 512 * 2 <= WS_CQR, "map1");
static_assert(WS_CQR + (size_t)MT * 384 * 2 <= WS_CKVB && WS_CKVB + (size_t)KVR * 256 * 2 <= WS_KRB && WS_KRB + (size_t)KVR * 32 * 2 <= WS_MQ && WS_MQ + (size_t)MT * 768 * 2 <= WS_MKN, "map2");
static_assert(WS_MKN + (size_t)KVR * 512 * 2 <= WS_MV && WS_MV + (size_t)KVR * 512 * 2 <= WS_END && WS_XN + (size_t)MT * 1024 * 2 <= WS_D, "map3");
static_assert(WS_XB + (size_t)MT * 1024 * 2 <= WS_CQ && WS_CQ + (size_t)MT * 512 * 2 <= WS_CO && WS_CO + (size_t)MT * 512 * 2 <= WS_H, "map4");

struct Params { const float* in[31]; float* out; unsigned char* ws; int ph_lo, ph_hi; };

__device__ __forceinline__ unsigned pk2(float lo, float hi) { f32x2 v = {lo, hi}; bf16x2_t b = __builtin_convertvector(v, bf16x2_t); return __builtin_bit_cast(unsigned, b); }
__device__ __forceinline__ u32x2 pk4(f32x4 v) { return (u32x2){pk2(v[0], v[1]), pk2(v[2], v[3])}; }
__device__ __forceinline__ float dot4(f32x4 v) { return (v[0] * v[0] + v[1] * v[1]) + (v[2] * v[2] + v[3] * v[3]); }
__device__ __forceinline__ float wave_sum(float v) {
#pragma unroll
    for (int o = 1; o < 64; o <<= 1) v += __shfl_xor(v, o);
    return v;
}
__device__ __forceinline__ int kvrow(int r) { return r < MP ? r : MP + ((r - MP) >> 6) * SKV + PAST + ((r - MP) & 63); }
__device__ __forceinline__ int rowpos(int r) { return r < MP ? (r & 4095) : PAST + ((r - MP) & 63); }
#define LDS_WAIT() asm volatile("s_waitcnt lgkmcnt(0)" ::: "memory")

__constant__ double ROPE_INV[16] = {1.0, 0.5623413251903491, 0.31622776601683794, 0.1778279410038923, 0.1, 0.05623413251903491, 0.031622776601683794, 0.01778279410038923,
                                    0.01, 0.005623413251903491, 0.0031622776601683794, 0.001778279410038923, 0.001, 0.0005623413251903491, 0.00031622776601683794, 0.0001778279410038923};

#define EPI_ARGS const pg8::f32x4 (&acc)[2][2][4][2], const pg8::Unit& u, int wr, int wc, int fr, int fq
#define FOR_AI_M _Pragma("unroll") for (int ai = 0; ai < 2; ++ai) _Pragma("unroll") for (int m = 0; m < 4; ++m)
#define FOR_BJ_N _Pragma("unroll") for (int bj = 0; bj < 2; ++bj) _Pragma("unroll") for (int n = 0; n < 2; ++n)

struct Epi1 {
    static constexpr bool PERM = false, AFTER_DRAIN = false;
    bf16_t *QF, *KF, *VF, *CQR; float *ZS, *SSQQ, *out;
    __device__ __forceinline__ void operator()(EPI_ARGS) const {
        const int pn = u.pn, row0 = u.pm * 256 + wr * 64 + fr, cw = wc * 32 + 4 * fq; const bool samp = u.pm >= 256;
        if (pn < 2) {
            FOR_AI_M { const int row = row0 + ai * 128 + m * 16; bf16_t* p = QF + (size_t)row * 512 + pn * 256 + cw;
                FOR_BJ_N { const f32x4 v = acc[ai][bj][m][n] * QS_FOX; *(u32x2*)(p + bj * 128 + n * 16) = pk4(v); } }
        } else if (pn < 6) {
            const bool isV = pn >= 4; bf16_t* B = isV ? VF : KF;
            float* O = out + (samp ? (isV ? OFF_S_FOX_V : OFF_S_FOX_K) : (isV ? OFF_P_FOX_V : OFF_P_FOX_K));
            const int cb = (pn & 1) * 256 + cw;
            FOR_AI_M { const int row = row0 + ai * 128 + m * 16, orow = samp ? row - MP : row, kr = kvrow(row);
                float* po = O + (size_t)orow * 512 + cb; bf16_t* pb = B + (size_t)kr * 512 + cb;
                FOR_BJ_N { const f32x4 v = acc[ai][bj][m][n]; *(f32x4*)(po + bj * 128 + n * 16) = v; *(u32x2*)(pb + bj * 128 + n * 16) = pk4(v); } }
        } else {
            FOR_AI_M { const int row = row0 + ai * 128 + m * 16; float ss = 0.f;
#pragma unroll
                for (int bj = 0; bj < 2; ++bj) { const int gc = pn * 256 + bj * 128;
                    if (gc < 1920) { bf16_t* p = CQR + (size_t)row * 384 + (gc - 1536) + cw;
#pragma unroll
                        for (int n = 0; n < 2; ++n) { const f32x4 v = acc[ai][bj][m][n]; *(u32x2*)(p + n * 16) = pk4(v); ss += dot4(v); } }
                    else { float* p = ZS + (size_t)row * 384 + (gc - 1920) + cw;
#pragma unroll
                        for (int n = 0; n < 2; ++n) *(f32x4*)(p + n * 16) = acc[ai][bj][m][n]; } }
                if (pn * 256 < 1920) { ss += __shfl_xor(ss, 16); ss += __shfl_xor(ss, 32); if (fq == 0) unsafeAtomicAdd(SSQQ + row, ss); } }
        }
    }
};
struct EpiM {
    static constexpr bool PERM = false, AFTER_DRAIN = false;
    bf16_t *MEMK, *MEMV; float* out;
    __device__ __forceinline__ void operator()(EPI_ARGS) const {
        const bool isV = u.pn >= 2; bf16_t* B = isV ? MEMV : MEMK; float* O = out + (isV ? OFF_P_MEM_V : OFF_P_MEM_K);
        const int row0 = u.pm * 256 + wr * 64 + fr, cb = (u.pn & 1) * 256 + wc * 32 + 4 * fq;
        FOR_AI_M { const int row = row0 + ai * 128 + m * 16; float* po = O + (size_t)row * 512 + cb; bf16_t* pb = B + (size_t)row * 512 + cb;
            FOR_BJ_N { const f32x4 v = acc[ai][bj][m][n]; *(f32x4*)(po + bj * 128 + n * 16) = v; *(u32x2*)(pb + bj * 128 + n * 16) = pk4(v); } }
    }
};
struct Epi3 {
    static constexpr bool PERM = false, AFTER_DRAIN = false;
    bf16_t *MKN, *MV;
    __device__ __forceinline__ void operator()(EPI_ARGS) const {
        bf16_t* B = (wc >= 2) ? MV : MKN; const int cw = (wc & 1) * 32 + 4 * fq, row0 = u.pm * 256 + wr * 64 + fr;
        FOR_AI_M { const int row = row0 + ai * 128 + m * 16;
            FOR_BJ_N { bf16_t* p = B + (size_t)row * 512 + (2 * u.pn + bj) * 64 + cw + n * 16; *(u32x2*)p = pk4(acc[ai][bj][m][n]); } }
    }
};
template <bool XB_OUT> struct EpiRes {
    static constexpr bool PERM = false, AFTER_DRAIN = false;
    const float *bp, *bs; float* Y; bf16_t* XB; float* SSQ;
    __device__ __forceinline__ void operator()(EPI_ARGS) const {
        const int row0 = u.pm * 256 + wr * 64 + fr, cb = u.pn * 256 + wc * 32 + 4 * fq;
        FOR_AI_M { const int row = row0 + ai * 128 + m * 16;
            const float* b = (u.pm >= 256) ? bs + (size_t)(row - MP) * 1024 : bp + (size_t)row * 1024; float* y = Y + (size_t)row * 1024; float ss = 0.f;
            FOR_BJ_N { const int off = cb + bj * 128 + n * 16; const f32x4 v = acc[ai][bj][m][n] + *(const f32x4*)(b + off); *(f32x4*)(y + off) = v;
                if (XB_OUT) *(u32x2*)(XB + (size_t)row * 1024 + off) = pk4(v); ss += dot4(v); }
            ss += __shfl_xor(ss, 16); ss += __shfl_xor(ss, 32); if (fq == 0) unsafeAtomicAdd(SSQ + row, ss);
            asm volatile("" ::: "memory"); }
    }
};
struct EpiScale {
    static constexpr bool PERM = false, AFTER_DRAIN = false;
    bf16_t* O; int ldo; const float* SSQ; float inv_n, qs;
    __device__ __forceinline__ void operator()(EPI_ARGS) const {
        const int row0 = u.pm * 256 + wr * 64 + fr, cb = u.pn * 256 + wc * 32 + 4 * fq;
        FOR_AI_M { const int row = row0 + ai * 128 + m * 16; const float rs = rsqrtf(SSQ[row] * inv_n + EPS) * qs; bf16_t* p = O + (size_t)row * ldo + cb;
            FOR_BJ_N { *(u32x2*)(p + bj * 128 + n * 16) = pk4(acc[ai][bj][m][n] * rs); } }
    }
};
struct EpiGLU {
    static constexpr bool PERM = false, AFTER_DRAIN = false;
    bf16_t* H; const float* SSQ;
    __device__ __forceinline__ void operator()(EPI_ARGS) const {
        const int row0 = u.pm * 256 + wr * 64 + fr, cb = u.pn * 128 + wc * 32 + 4 * fq;
        FOR_AI_M { const int row = row0 + ai * 128 + m * 16; const float rs = rsqrtf(SSQ[row] * (1.0f / 1024.0f) + EPS); bf16_t* p = H + (size_t)row * 2816 + cb;
#pragma unroll
            for (int n = 0; n < 2; ++n) { const f32x4 g = acc[ai][0][m][n] * rs, uu = acc[ai][1][m][n] * rs; f32x4 h;
#pragma unroll
                for (int e = 0; e < 4; ++e) h[e] = g[e] * uu[e] * __builtin_amdgcn_rcpf(1.0f + __builtin_amdgcn_exp2f(-g[e] * LOG2E));
                *(u32x2*)(p + n * 16) = pk4(h); } }
    }
};

struct AttnUnit {
    const bf16_t* Q; int ldq;
    const bf16_t* K; int ldk;
    const bf16_t* K2;
    const bf16_t* V; int ldv;
    const float* CK;
    const float* ROPE;
    bf16_t* O; int ldo;
    int nrows, qpos0, NT;
};
__device__ __forceinline__ int crow(int r, int hi) { return (r & 3) + 8 * (r >> 2) + 4 * hi; }
__device__ __forceinline__ s16x4 vtr(const LAS unsigned char* p) {
    typedef short v4i16_t __attribute__((ext_vector_type(4)));
    return __builtin_bit_cast(s16x4, __builtin_amdgcn_ds_read_tr16_b64_v4i16((LAS v4i16_t*)p));
}
template <int DK, int DV, int MODE>
__device__ __forceinline__ void attn_unit(const AttnUnit& d, LAS unsigned char* lds) {
    constexpr int DKM = (MODE == 1) ? 64 : DK;
    constexpr int KS = DK * 2 + 16;
    constexpr int NKC = DKM / 64, NVC = DV / 64, VSUB = DV / 32, CPRK = DKM / 8, CPRV = DV / 8;
    constexpr int KB0 = 0, KBS = 17408, VB0 = 34816, VBS = 16384, CKO = 67584;
    int tid_ = threadIdx.x; asm volatile("" : "+v"(tid_)); const int tid = tid_, lane = tid & 63, wid = __builtin_amdgcn_readfirstlane(tid >> 6), r32 = lane & 31, hi = lane >> 5;
    const bool wact = (wid * 32 < d.nrows);
    const int qpw = d.qpos0 + wid * 32;
    int tmax = (MODE == 0) ? ((qpw + 31) >> 6) : (MODE == 1) ? (qpw >> 6) : (d.NT - 1);
    if (!wact) tmax = -1;
    const int NT = d.NT;
    bf16x8 qf[DK / 16];
    {
        const bf16_t* qp = d.Q + (size_t)((wact ? wid * 32 : 0) + r32) * d.ldq + hi * 8;
#pragma unroll
        for (int ks = 0; ks < DK / 16; ++ks) qf[ks] = *(const bf16x8*)(qp + ks * 16);
    }
    if (MODE == 1) {
        const int pos = (wact ? qpw : d.qpos0) + r32; const float* cp = d.ROPE + pos * 16 + hi * 8;
        const f32x4 c0 = *(const f32x4*)cp, c1 = *(const f32x4*)(cp + 4), s0 = *(const f32x4*)(cp + 65536), s1 = *(const f32x4*)(cp + 65540);
        const u32x4 a = __builtin_bit_cast(u32x4, qf[4]), b = __builtin_bit_cast(u32x4, qf[5]); u32x4 oa, ob;
#pragma unroll
        for (int k = 0; k < 4; ++k) {
            const float x1l = __uint_as_float(a[k] << 16), x1h = __uint_as_float(a[k] & 0xffff0000u), x2l = __uint_as_float(b[k] << 16), x2h = __uint_as_float(b[k] & 0xffff0000u);
            const float cl = (k < 2) ? c0[2 * k] : c1[2 * k - 4], ch = (k < 2) ? c0[2 * k + 1] : c1[2 * k - 3], sl = (k < 2) ? s0[2 * k] : s1[2 * k - 4], sh = (k < 2) ? s0[2 * k + 1] : s1[2 * k - 3];
            oa[k] = pk2(x1l * cl - x2l * sl, x1h * ch - x2h * sh); ob[k] = pk2(x2l * cl + x1l * sl, x2h * ch + x1h * sh);
        }
        qf[4] = __builtin_bit_cast(bf16x8, oa); qf[5] = __builtin_bit_cast(bf16x8, ob);
    }
    float cq = 0.f;
    if (MODE == 0) cq = d.CK[(size_t)((wact ? qpw : d.qpos0) + r32) * 8];
    u32x4 kreg[NKC], vreg[NVC], k2reg = (u32x4){0u, 0u, 0u, 0u}; float ckreg = 0.f;
#define ATT_LOAD(t) do { \
        _Pragma("unroll") for (int i_ = 0; i_ < NKC; ++i_) { const int id_ = tid + 512 * i_, row_ = id_ / CPRK, c_ = id_ % CPRK; \
            kreg[i_] = *(const u32x4*)(d.K + (size_t)((t) * 64 + row_) * d.ldk + c_ * 8); } \
        _Pragma("unroll") for (int i_ = 0; i_ < NVC; ++i_) { const int id_ = tid + 512 * i_, row_ = id_ / CPRV, c_ = id_ % CPRV; \
            vreg[i_] = *(const u32x4*)(d.V + (size_t)((t) * 64 + row_) * d.ldv + c_ * 8); } \
        if (MODE == 1) { if (tid < 256) k2reg = *(const u32x4*)(d.K2 + (size_t)((t) * 64 + (tid >> 2)) * 32 + (tid & 3) * 8); } \
        if (MODE == 0) { if (tid < 64) ckreg = d.CK[(size_t)((t) * 64 + tid) * 8]; } } while (0)
#define ATT_STORE(buf) do { \
        _Pragma("unroll") for (int i_ = 0; i_ < NKC; ++i_) { const int id_ = tid + 512 * i_, row_ = id_ / CPRK, c_ = id_ % CPRK; \
            *(LAS u32x4*)(lds + KB0 + (buf) * KBS + row_ * KS + c_ * 16) = kreg[i_]; } \
        _Pragma("unroll") for (int i_ = 0; i_ < NVC; ++i_) { const int id_ = tid + 512 * i_, row_ = id_ / CPRV, c_ = id_ % CPRV; \
            *(LAS u32x4*)(lds + VB0 + (buf) * VBS + ((row_ >> 3) * VSUB + (c_ >> 2)) * 512 + (row_ & 7) * 64 + (c_ & 3) * 16) = vreg[i_]; } \
        if (MODE == 1) { if (tid < 256) *(LAS u32x4*)(lds + KB0 + (buf) * KBS + (tid >> 2) * KS + 128 + (tid & 3) * 16) = k2reg; } \
        if (MODE == 0) { if (tid < 64) *(LAS float*)(lds + CKO + (buf) * 256 + tid * 4) = ckreg; } } while (0)
    f32x16 o[VSUB];
#pragma unroll
    for (int db = 0; db < VSUB; ++db)
#pragma unroll
        for (int i = 0; i < 16; ++i) o[db][i] = 0.f;
    float mrun = -1e30f, lrun = 0.f;
    ATT_LOAD(0); ATT_STORE(0); __syncthreads();
    for (int t = 0; t < NT; ++t) {
        const int buf = t & 1;
        if (t + 1 < NT) ATT_LOAD(t + 1);
        if (t <= tmax) {
            f32x16 s[2];
#pragma unroll
            for (int sb = 0; sb < 2; ++sb) {
                f32x16 c;
#pragma unroll
                for (int i = 0; i < 16; ++i) c[i] = 0.f;
                const LAS unsigned char* kp = lds + KB0 + buf * KBS + (sb * 32 + r32) * KS + hi * 16;
#pragma unroll
                for (int ks = 0; ks < DK / 16; ++ks) { const bf16x8 a = *(const LAS bf16x8*)(kp + ks * 32); c = __builtin_amdgcn_mfma_f32_32x32x16_bf16(a, qf[ks], c, 0, 0, 0); }
                s[sb] = c;
            }
            if (MODE == 0) {
#pragma unroll
                for (int sb = 0; sb < 2; ++sb)
#pragma unroll
                    for (int g = 0; g < 4; ++g) { const f32x4 ck = *(const LAS f32x4*)(lds + CKO + buf * 256 + (sb * 32 + 8 * g + 4 * hi) * 4);
#pragma unroll
                        for (int e = 0; e < 4; ++e) s[sb][4 * g + e] += cq - ck[e]; }
                if (t * 64 + 63 > qpw) {
                    const int qp = qpw + r32;
#pragma unroll
                    for (int sb = 0; sb < 2; ++sb)
#pragma unroll
                        for (int i = 0; i < 16; ++i) { const int kvp = t * 64 + sb * 32 + crow(i, hi); if (kvp > qp) s[sb][i] = -1e30f; }
                }
            }
            float mx = s[0][0];
#pragma unroll
            for (int i = 1; i < 16; ++i) mx = fmaxf(mx, s[0][i]);
#pragma unroll
            for (int i = 0; i < 16; ++i) mx = fmaxf(mx, s[1][i]);
            mx = fmaxf(mx, __shfl_xor(mx, 32));
            const float mnew = fmaxf(mrun, mx), alpha = __builtin_amdgcn_exp2f(mrun - mnew); mrun = mnew;
            float ps = 0.f;
#pragma unroll
            for (int sb = 0; sb < 2; ++sb)
#pragma unroll
                for (int i = 0; i < 16; ++i) { const float p = __builtin_amdgcn_exp2f(s[sb][i] - mnew); s[sb][i] = p; ps += p; }
            lrun = lrun * alpha + ps;
#pragma unroll
            for (int db = 0; db < VSUB; ++db)
#pragma unroll
                for (int i = 0; i < 16; ++i) o[db][i] *= alpha;
            bf16x8 pf[4];
#pragma unroll
            for (int st = 0; st < 4; ++st) { const int sb = st >> 1, b8 = (st & 1) * 8;
                u32x4 w; w[0] = pk2(s[sb][b8 + 0], s[sb][b8 + 1]); w[1] = pk2(s[sb][b8 + 2], s[sb][b8 + 3]); w[2] = pk2(s[sb][b8 + 4], s[sb][b8 + 5]); w[3] = pk2(s[sb][b8 + 6], s[sb][b8 + 7]);
                pf[st] = __builtin_bit_cast(bf16x8, w); }
            const LAS unsigned char* vp = lds + VB0 + buf * VBS + (4 * hi + ((lane & 15) >> 2)) * 64 + ((lane >> 4) & 1) * 32 + (lane & 3) * 8;
#pragma unroll
            for (int db = 0; db < VSUB; ++db)
#pragma unroll
                for (int st = 0; st < 4; ++st) {
                    const s16x4 lo = vtr(vp + ((2 * st) * VSUB + db) * 512), hh = vtr(vp + ((2 * st + 1) * VSUB + db) * 512);
                    const bf16x8 vf = __builtin_shufflevector(lo, hh, 0, 1, 2, 3, 4, 5, 6, 7);
                    o[db] = __builtin_amdgcn_mfma_f32_32x32x16_bf16(vf, pf[st], o[db], 0, 0, 0);
                }
        }
        if (t + 1 < NT) ATT_STORE(buf ^ 1);
        __syncthreads();
    }
    if (wact) {
        const float lt = lrun + __shfl_xor(lrun, 32), inv = 1.0f / lt;
        bf16_t* op = d.O + (size_t)(wid * 32 + r32) * d.ldo + 4 * hi;
#pragma unroll
        for (int db = 0; db < VSUB; ++db)
#pragma unroll
            for (int g = 0; g < 4; ++g) { const f32x4 v = (f32x4){o[db][4 * g], o[db][4 * g + 1], o[db][4 * g + 2], o[db][4 * g + 3]} * inv; *(u32x2*)(op + db * 32 + 8 * g) = pk4(v); }
    }
#undef ATT_LOAD
#undef ATT_STORE
}

__device__ __forceinline__ void transpose_item(const float* __restrict__ W, int ldw, int srccol0, int nvalid, const float* __restrict__ gk,
                                               bf16_t* WT, int K, int dstrow0, int k0, LAS float* scr, int lane) {
#pragma unroll 8
    for (int i = 0; i < 32; ++i) { const int kk = 2 * i + (lane >> 5), n = lane & 31; float v = 0.f;
        if (n < nvalid) { v = W[(size_t)(k0 + kk) * ldw + srccol0 + n]; if (gk) v *= gk[k0 + kk]; }
        scr[kk * 33 + n] = v; }
    LDS_WAIT();
    const int c = lane & 7;
#pragma unroll
    for (int j = 0; j < 4; ++j) { const int n = (lane >> 3) + 8 * j; const LAS float* s = scr + (8 * c) * 33 + n;
        u32x4 o; o.x = pk2(s[0 * 33], s[1 * 33]); o.y = pk2(s[2 * 33], s[3 * 33]); o.z = pk2(s[4 * 33], s[5 * 33]); o.w = pk2(s[6 * 33], s[7 * 33]);
        *(u32x4*)(WT + (size_t)(dstrow0 + n) * K + k0 + 8 * c) = o; }
    LDS_WAIT();
}
__device__ __forceinline__ void rms_row_to_bf16(const float* xrow, const float* g, bf16_t* orow, int lane) {
    f32x4 v[4]; float s = 0.f;
#pragma unroll
    for (int j = 0; j < 4; ++j) { v[j] = ((const f32x4*)xrow)[lane + 64 * j]; s += dot4(v[j]); }
    const float rstd = rsqrtf(wave_sum(s) * (1.0f / 1024.0f) + EPS);
#pragma unroll
    for (int j = 0; j < 4; ++j) { const f32x4 gg = ((const f32x4*)g)[lane + 64 * j]; ((u32x2*)orow)[lane + 64 * j] = pk4(v[j] * rstd * gg); }
}
__device__ __forceinline__ void cvt_rows(const float* src, bf16_t* dst, int nrows, int W8, int rpg, int drow0, int dstride, size_t gtid, size_t gthreads) {
    const size_t total = (size_t)nrows * W8;
    for (size_t idx = gtid; idx < total; idx += gthreads) {
        const int row = (int)(idx / W8), c8 = (int)(idx % W8), drow = drow0 + (row / rpg) * dstride + (row % rpg);
        const f32x4 a = *(const f32x4*)(src + idx * 8), b = *(const f32x4*)(src + idx * 8 + 4);
        *(u32x4*)(dst + ((size_t)drow * W8 + c8) * 8) = (u32x4){pk2(a[0], a[1]), pk2(a[2], a[3]), pk2(b[0], b[1]), pk2(b[2], b[3])};
    }
}

constexpr int LDS_BYTES = 135168;
__global__ void __launch_bounds__(NTHR, 2) fwd_kernel(Params P) {
    extern __shared__ __attribute__((aligned(16))) unsigned char lds_raw[];
    LAS unsigned char* lds = (LAS unsigned char*)lds_raw;
    cg::grid_group grid = cg::this_grid();
    const int wid = __builtin_amdgcn_readfirstlane(threadIdx.x >> 6);
    const int G = gridDim.x, bx = blockIdx.x;
#define FRESH_TID() int tid_ = threadIdx.x; asm volatile("" : "+v"(tid_)); const int tid = tid_, lane = tid & 63; (void)lane; const size_t gtid = (size_t)bx * NTHR + tid; (void)gtid
    const int vcu = (G % 8 == 0) ? (bx % 8) * (G / 8) + bx / 8 : bx;
    const int gw = bx * 8 + wid, NGW = G * 8;
    const size_t gthreads = (size_t)G * NTHR;
    unsigned char* ws = P.ws; float* out = P.out;
    bf16_t *W_IN = (bf16_t*)(ws + WS_W_IN), *W_UQ = (bf16_t*)(ws + WS_W_UQ), *W_UKV = (bf16_t*)(ws + WS_W_UKV), *W_O = (bf16_t*)(ws + WS_W_O), *W_MKV = (bf16_t*)(ws + WS_W_MKV),
           *W_MQ = (bf16_t*)(ws + WS_W_MQ), *W_MO = (bf16_t*)(ws + WS_W_MO), *W_GU = (bf16_t*)(ws + WS_W_GU), *W_D = (bf16_t*)(ws + WS_W_D);
    float *COS = (float*)(ws + WS_ROPE), *SIN = COS + 4096 * 16;
    float *SSQQ = (float*)(ws + WS_SSQ), *SSQ1 = SSQQ + MT, *SSQ2 = SSQ1 + MT, *SSQ3 = SSQ2 + MT;
    float* CUM = (float*)(ws + WS_CUM);
    bf16_t *MEMK = (bf16_t*)(ws + WS_MEMK), *MEMV = (bf16_t*)(ws + WS_MEMV), *MN = (bf16_t*)(ws + WS_MN), *XN = (bf16_t*)(ws + WS_XN), *ATT = XN;
    float* ZS = (float*)(ws + WS_ZS);
    bf16_t *QF = (bf16_t*)(ws + WS_QF), *KF = (bf16_t*)(ws + WS_KF), *VF = (bf16_t*)(ws + WS_VF), *CQR = (bf16_t*)(ws + WS_CQR), *CKVB = (bf16_t*)(ws + WS_CKVB), *KRB = (bf16_t*)(ws + WS_KRB),
           *MQ = (bf16_t*)(ws + WS_MQ), *MKN = (bf16_t*)(ws + WS_MKN), *MV = (bf16_t*)(ws + WS_MV);
    bf16_t *XB = (bf16_t*)(ws + WS_XB), *CQ = (bf16_t*)(ws + WS_CQ), *CO = (bf16_t*)(ws + WS_CO), *HB = (bf16_t*)(ws + WS_H);
    const int lo = P.ph_lo, hi_ph = P.ph_hi;
#ifndef PHASE_MASK
#define PHASE_MASK 0x1fff
#endif
#define IN(k) (((PHASE_MASK >> (k)) & 1) && lo <= (k) && (k) < hi_ph)
#define SEAM(k) do { if (IN(k) && IN((k) + 1)) grid.sync(); } while (0)

    if (IN(0)) {
        FRESH_TID();
        for (size_t i = gtid; i < (size_t)4 * MT; i += gthreads) SSQQ[i] = 0.f;
        for (size_t i = gtid; i < (size_t)4096 * 16; i += gthreads) {
            const int pos = (int)(i >> 4), j = (int)(i & 15); const double a = (double)pos * ROPE_INV[j] * 0.15915494309189535; const float fr_ = (float)(a - floor(a));
            COS[i] = __builtin_amdgcn_cosf(fr_); SIN[i] = __builtin_amdgcn_sinf(fr_);
        }
        {
            LAS float* scr = (LAS float*)(lds + wid * 16384);
            constexpr int I1 = 16 * 72, I2 = 6 * 24, I3 = 4 * 32, I4 = 16 * 32, I5 = 16 * 32, I6 = 16 * 16, I7 = 8 * 32, I8 = 16 * 176, I9 = 44 * 32;
            constexpr int NIT = I1 + I2 + I3 + I4 + I5 + I6 + I7 + I8 + I9;
            for (int it = gw; it < NIT; it += NGW) {
                int r = it;
                if (r < I1) { const int kb = r / 72, nb = r % 72, n0 = nb * 32; int src, nv;
                    if (n0 < 1536) { src = n0; nv = 32; } else if (n0 < 2208) { src = n0 + 8; nv = 32; } else if (n0 == 2208) { src = 1536; nv = 8; } else { src = 0; nv = 0; }
                    transpose_item(P.in[11], 2216, src, nv, nullptr, W_IN, 1024, n0, kb * 64, scr, lane); continue; } r -= I1;
                if (r < I2) { const int kb = r / 24, nb = r % 24; transpose_item(P.in[14], 768, nb * 32, 32, P.in[13], W_UQ, 384, nb * 32, kb * 64, scr, lane); continue; } r -= I2;
                if (r < I3) { const int kb = r / 32, nb = r % 32; transpose_item(P.in[16], 1024, nb * 32, 32, nullptr, W_UKV, 256, nb * 32, kb * 64, scr, lane); continue; } r -= I3;
                if (r < I4) { const int kb = r / 32, nb = r % 32; transpose_item(P.in[19], 1024, nb * 32, 32, nullptr, W_O, 1024, nb * 32, kb * 64, scr, lane); continue; } r -= I4;
                if (r < I5) { const int kb = r / 32, nb = r % 32; transpose_item(nb < 16 ? P.in[21] : P.in[22], 512, (nb & 15) * 32, 32, nullptr, W_MKV, 1024, nb * 32, kb * 64, scr, lane); continue; } r -= I5;
                if (r < I6) { const int kb = r / 16, nb = r % 16; transpose_item(P.in[24], 512, nb * 32, 32, P.in[23], W_MQ, 1024, nb * 32, kb * 64, scr, lane); continue; } r -= I6;
                if (r < I7) { const int kb = r / 32, nb = r % 32; transpose_item(P.in[25], 1024, nb * 32, 32, nullptr, W_MO, 512, nb * 32, kb * 64, scr, lane); continue; } r -= I7;
                if (r < I8) { const int kb = r / 176, nb = r % 176, tile = nb >> 3, j = nb & 7;
                    transpose_item(j < 4 ? P.in[27] : P.in[28], 2816, tile * 128 + (j & 3) * 32, 32, P.in[26], W_GU, 1024, nb * 32, kb * 64, scr, lane); continue; } r -= I8;
                { const int kb = r / 32, nb = r % 32; transpose_item(P.in[29], 1024, nb * 32, 32, nullptr, W_D, 2816, nb * 32, kb * 64, scr, lane); }
            }
        }
        for (int m = gw; m < MT; m += NGW) rms_row_to_bf16(m < MP ? P.in[0] + (size_t)m * 1024 : P.in[1] + (size_t)(m - MP) * 1024, P.in[10], XN + (size_t)m * 1024, lane);
        for (int m = gw; m < 4096; m += NGW) rms_row_to_bf16(P.in[2] + (size_t)m * 1024, P.in[20], MN + (size_t)m * 1024, lane);
        cvt_rows(P.in[3], KF, 16384, 64, 2048, MP, SKV, gtid, gthreads);
        cvt_rows(P.in[4], VF, 16384, 64, 2048, MP, SKV, gtid, gthreads);
        cvt_rows(P.in[6], CKVB, 16384, 32, 2048, MP, SKV, gtid, gthreads);
        cvt_rows(P.in[7], KRB, 16384, 4, 2048, MP, SKV, gtid, gthreads);
        cvt_rows(P.in[8], MEMK, 2048, 64, 2048, 4096, 0, gtid, gthreads);
        cvt_rows(P.in[9], MEMV, 2048, 64, 2048, 4096, 0, gtid, gthreads);
    }
    SEAM(0);
    if (IN(1)) {
        { pg8::Gemm g{XN, W_IN, MT, 2304, 1024}; pg8::StaticOrder S; S.init(MT, 2304, G, bx); Epi1 E{QF, KF, VF, CQR, ZS, SSQQ, out};
          pg8::gemm_phase<Epi1, pg8::StaticOrder, true, true>(lds, g, S, E); }
        { pg8::Gemm g{MN, W_MKV, 4096, 1024, 1024}; pg8::StaticOrder S; S.init(4096, 1024, G, (bx + 64) % G); EpiM E{MEMK, MEMV, out};
          pg8::gemm_phase<EpiM, pg8::StaticOrder, true, true>(lds, g, S, E); }
    }
    SEAM(1);
    if (IN(2)) {
        FRESH_TID();
        for (int r = gw; r < MT; r += NGW) {
            const float* z = ZS + (size_t)r * 384; const bool samp = r >= MP; const int orow = samp ? r - MP : r, kr = kvrow(r);
            const f32x4 v = *(const f32x4*)(z + 4 * lane); const float rstd = rsqrtf(wave_sum(dot4(v)) * (1.0f / 256.0f) + EPS);
            const f32x4 ov = v * rstd * *(const f32x4*)(P.in[15] + 4 * lane);
            *(f32x4*)(out + (samp ? OFF_S_CKV : OFF_P_CKV) + (size_t)orow * 256 + 4 * lane) = ov;
            *(u32x2*)(CKVB + (size_t)kr * 256 + 4 * lane) = pk4(ov);
            if (lane < 16) { const float x1 = z[256 + lane], x2 = z[272 + lane]; const int pos = rowpos(r); const float c = COS[pos * 16 + lane], s = SIN[pos * 16 + lane];
                const float o1 = x1 * c - x2 * s, o2 = x2 * c + x1 * s; float* po = out + (samp ? OFF_S_KR : OFF_P_KR) + (size_t)orow * 32;
                po[lane] = o1; po[lane + 16] = o2; bf16_t* pb = KRB + (size_t)kr * 32; pb[lane] = (bf16_t)(pk2(o1, 0.f) & 0xffffu); pb[lane + 16] = (bf16_t)(pk2(o2, 0.f) & 0xffffu); }
            if (lane < 8) { const float f = z[288 + lane] + P.in[12][lane]; const float lf = fminf(f, 0.f) - log1pf(__expf(-fabsf(f)));
                out[(samp ? OFF_S_LOGF : OFF_P_LOGF) + (size_t)orow * 8 + lane] = lf; }
        }
    }
    SEAM(2);
    if (IN(3)) {
        FRESH_TID();
        for (int job = bx; job < 24; job += G) {
            LAS float* TS = (LAS float*)lds; const bool samp = job >= 16; const int sb = job - 16, nthr = samp ? 264 : 512;
            const float* src; if (!samp) src = out + OFF_P_LOGF + ((size_t)job * 4096 + tid * 8) * 8; else if (tid < 256) src = P.in[5] + ((size_t)sb * 2048 + tid * 8) * 8; else src = out + OFF_S_LOGF + ((size_t)sb * 64 + (tid - 256) * 8) * 8;
            float s[8];
#pragma unroll
            for (int k = 0; k < 8; ++k) s[k] = 0.f;
            if (tid < nthr) {
#pragma unroll
                for (int r = 0; r < 8; ++r) { const f32x4 a = *(const f32x4*)(src + r * 8), b = *(const f32x4*)(src + r * 8 + 4);
                    s[0] += a[0]; s[1] += a[1]; s[2] += a[2]; s[3] += a[3]; s[4] += b[0]; s[5] += b[1]; s[6] += b[2]; s[7] += b[3]; }
            }
#pragma unroll
            for (int k = 0; k < 8; ++k) TS[tid * 8 + k] = s[k];
            __syncthreads();
            { float part = 0.f, loc[8];
#pragma unroll
                for (int k = 0; k < 8; ++k) { loc[k] = part; part += TS[(lane * 8 + k) * 8 + wid]; }
                float inc = part;
#pragma unroll
                for (int o = 1; o < 64; o <<= 1) { const float t = __shfl_up(inc, o); if (lane >= o) inc += t; }
                const float exc = inc - part;
#pragma unroll
                for (int k = 0; k < 8; ++k) TS[(lane * 8 + k) * 8 + wid] = exc + loc[k]; }
            __syncthreads();
            if (tid < nthr) {
#pragma unroll
                for (int k = 0; k < 8; ++k) s[k] = TS[tid * 8 + k];
                float* dst = CUM + ((size_t)(samp ? MP + sb * SKV : job * 4096) + tid * 8) * 8;
#pragma unroll
                for (int r = 0; r < 8; ++r) { const f32x4 a = *(const f32x4*)(src + r * 8), b = *(const f32x4*)(src + r * 8 + 4);
                    s[0] += a[0]; s[1] += a[1]; s[2] += a[2]; s[3] += a[3]; s[4] += b[0]; s[5] += b[1]; s[6] += b[2]; s[7] += b[3];
                    *(f32x4*)(dst + r * 8) = (f32x4){s[0], s[1], s[2], s[3]} * LOG2E; *(f32x4*)(dst + r * 8 + 4) = (f32x4){s[4], s[5], s[6], s[7]} * LOG2E; }
            }
            __syncthreads();
        }
        { pg8::Gemm g{CQR, W_UQ, MT, 768, 384}; pg8::StaticOrder S; S.init(MT, 768, G, bx); EpiScale E{MQ, 768, SSQQ, 1.0f / 384.0f, QS_MLA};
          pg8::gemm_phase<EpiScale, pg8::StaticOrder, true, true>(lds, g, S, E); }
        { pg8::Gemm g{CKVB, W_UKV, KVR, 1024, 256}; pg8::StaticOrder S; S.init(KVR, 1024, G, bx); Epi3 E{MKN, MV};
          pg8::gemm_phase<Epi3, pg8::StaticOrder, true, true>(lds, g, S, E); }
    }
    SEAM(3);
    if (IN(4)) {
        for (int uu = vcu; uu < 4224; uu += G) {
            AttnUnit d; bool mla; d.ROPE = COS;
            if (uu < 4096) {
                mla = uu >= 2048; const int u2 = uu & 2047, i = u2 >> 8, c = u2 & 255, bh = c >> 1, b = bh >> 3, h = bh & 7, qb = 2 * i + ((i & 1) ^ (c & 1));
                const size_t seq0 = (size_t)b * 4096, q0 = seq0 + qb * 256;
                d.nrows = 256; d.qpos0 = qb * 256; d.NT = (qb + 1) * 4;
                if (!mla) { d.Q = QF + q0 * 512 + h * 64; d.ldq = 512; d.K = KF + seq0 * 512 + h * 64; d.ldk = 512; d.K2 = nullptr; d.V = VF + seq0 * 512 + h * 64; d.ldv = 512; d.CK = CUM + seq0 * 8 + h; d.O = ATT + q0 * 1024 + h * 64; d.ldo = 1024; }
                else { d.Q = MQ + q0 * 768 + h * 96; d.ldq = 768; d.K = MKN + seq0 * 512 + h * 64; d.ldk = 512; d.K2 = KRB + seq0 * 32; d.V = MV + seq0 * 512 + h * 64; d.ldv = 512; d.CK = nullptr; d.O = ATT + q0 * 1024 + 512 + h * 64; d.ldo = 1024; }
            } else {
                const int u2 = uu - 4096; mla = u2 >= 64; const int sb = (u2 & 63) >> 3, h = u2 & 7;
                const size_t seq0 = (size_t)MP + (size_t)sb * SKV, q0 = (size_t)MP + sb * 64;
                d.nrows = 64; d.qpos0 = PAST; d.NT = 33;
                if (!mla) { d.Q = QF + q0 * 512 + h * 64; d.ldq = 512; d.K = KF + seq0 * 512 + h * 64; d.ldk = 512; d.K2 = nullptr; d.V = VF + seq0 * 512 + h * 64; d.ldv = 512; d.CK = CUM + seq0 * 8 + h; d.O = ATT + q0 * 1024 + h * 64; d.ldo = 1024; }
                else { d.Q = MQ + q0 * 768 + h * 96; d.ldq = 768; d.K = MKN + seq0 * 512 + h * 64; d.ldk = 512; d.K2 = KRB + seq0 * 32; d.V = MV + seq0 * 512 + h * 64; d.ldv = 512; d.CK = nullptr; d.O = ATT + q0 * 1024 + 512 + h * 64; d.ldo = 1024; }
            }
            if (!mla) attn_unit<64, 64, 0>(d, lds); else attn_unit<96, 64, 1>(d, lds);
        }
    }
    SEAM(4);
    if (IN(5)) {
        FRESH_TID();
        for (int r = gw; r < MT; r += NGW) {
            bf16_t* a = ATT + (size_t)r * 1024;
#pragma unroll
            for (int grp = 0; grp < 2; ++grp) {
                const u32x4 w = *(const u32x4*)(a + grp * 512 + lane * 8); float x[8];
#pragma unroll
                for (int k = 0; k < 4; ++k) { x[2 * k] = __uint_as_float(w[k] << 16); x[2 * k + 1] = __uint_as_float(w[k] & 0xffff0000u); }
                float ss = 0.f;
#pragma unroll
                for (int k = 0; k < 8; ++k) ss += x[k] * x[k];
                const float rstd = rsqrtf(wave_sum(ss) * (1.0f / 512.0f) + EPS); const float* g = P.in[17 + grp] + lane * 8;
                const f32x4 g0 = *(const f32x4*)g, g1 = *(const f32x4*)(g + 4);
                *(u32x4*)(a + grp * 512 + lane * 8) = (u32x4){pk2(x[0] * rstd * g0[0], x[1] * rstd * g0[1]), pk2(x[2] * rstd * g0[2], x[3] * rstd * g0[3]),
                                                              pk2(x[4] * rstd * g1[0], x[5] * rstd * g1[1]), pk2(x[6] * rstd * g1[2], x[7] * rstd * g1[3])};
            }
        }
    }
    SEAM(5);
    if (IN(6)) {
        pg8::Gemm g{ATT, W_O, MT, 1024, 1024}; pg8::StaticOrder S; S.init(MT, 1024, G, bx); EpiRes<true> E{P.in[0], P.in[1], out, XB, SSQ1};
        pg8::gemm_phase<EpiRes<true>, pg8::StaticOrder, true, true>(lds, g, S, E);
    }
    SEAM(6);
    if (IN(7)) {
        pg8::Gemm g{XB, W_MQ, MT, 512, 1024}; pg8::StaticOrder S; S.init(MT, 512, G, bx); EpiScale E{CQ, 512, SSQ1, 1.0f / 1024.0f, QS_MEM};
        pg8::gemm_phase<EpiScale, pg8::StaticOrder, true, true>(lds, g, S, E);
    }
    SEAM(7);
    if (IN(8)) {
        for (int uu = vcu; uu < 1024 + 32; uu += G) {
            AttnUnit d; d.ROPE = nullptr; d.K2 = nullptr; d.CK = nullptr; d.qpos0 = 0; d.NT = 4; d.ldq = 512; d.ldk = 512; d.ldv = 512; d.ldo = 512;
            if (uu < 1024) { const int rb = uu >> 2, h = uu & 3, b = rb >> 4; const size_t q0 = (size_t)rb * 256;
                d.nrows = 256; d.Q = CQ + q0 * 512 + h * 128; d.O = CO + q0 * 512 + h * 128; d.K = MEMK + (size_t)b * 256 * 512 + h * 128; d.V = MEMV + (size_t)b * 256 * 512 + h * 128; }
            else { const int u2 = uu - 1024, sb = u2 >> 2, h = u2 & 3; const size_t q0 = (size_t)MP + sb * 64;
                d.nrows = 64; d.Q = CQ + q0 * 512 + h * 128; d.O = CO + q0 * 512 + h * 128; d.K = MEMK + (size_t)(16 + sb) * 256 * 512 + h * 128; d.V = MEMV + (size_t)(16 + sb) * 256 * 512 + h * 128; }
            attn_unit<128, 128, 2>(d, lds);
        }
    }
    SEAM(8);
    if (IN(9)) {
        pg8::Gemm g{CO, W_MO, MT, 1024, 512}; pg8::StaticOrder S; S.init(MT, 1024, G, bx); EpiRes<true> E{out, out + (size_t)MP * 1024, out, XB, SSQ2};
        pg8::gemm_phase<EpiRes<true>, pg8::StaticOrder, true, true>(lds, g, S, E);
    }
    SEAM(9);
    if (IN(10)) {
        pg8::Gemm g{XB, W_GU, MT, 5632, 1024}; pg8::StaticOrder S; S.init(MT, 5632, G, bx); EpiGLU E{HB, SSQ2};
        pg8::gemm_phase<EpiGLU, pg8::StaticOrder, true, true>(lds, g, S, E);
    }
    SEAM(10);
    if (IN(11)) {
        pg8::Gemm g{HB, W_D, MT, 1024, 2816}; pg8::StaticOrder S; S.init(MT, 1024, G, bx); EpiRes<false> E{out, out + (size_t)MP * 1024, out, nullptr, SSQ3};
        pg8::gemm_phase<EpiRes<false>, pg8::StaticOrder, true, true>(lds, g, S, E);
    }
    SEAM(11);
    if (IN(12)) {
        FRESH_TID();
        for (int r = gw; r < MT; r += NGW) {
            float* y = out + (size_t)r * 1024; const float rstd = rsqrtf(SSQ3[r] * (1.0f / 1024.0f) + EPS);
#pragma unroll
            for (int j = 0; j < 4; ++j) { const f32x4 v = ((const f32x4*)y)[lane + 64 * j], gg = ((const f32x4*)P.in[30])[lane + 64 * j]; ((f32x4*)y)[lane + 64 * j] = v * rstd * gg; }
        }
    }
#undef IN
#undef SEAM
}

#ifndef N_LAUNCH_SPLIT
#define N_LAUNCH_SPLIT 0
#endif
extern "C" void kernel_launch(void* const* d_in, const int* in_sizes, int n_in, void* d_out, int out_size, void* d_ws, size_t ws_size, hipStream_t stream) {
    static int grid = 0;
    if (grid == 0) {
        if (n_in != 31 || (size_t)out_size != OUT_TOTAL || ws_size < WS_END) { fprintf(stderr, "kernel_launch: unexpected shapes: n_in %d out %d ws %zu\n", n_in, out_size, ws_size); grid = -1; return; }
        int dev = 0, cus = 0, per_cu = 0;
        hipGetDevice(&dev); hipDeviceGetAttribute(&cus, hipDeviceAttributeMultiprocessorCount, dev);
        if (hipFuncSetAttribute((const void*)fwd_kernel, hipFuncAttributeMaxDynamicSharedMemorySize, LDS_BYTES) != hipSuccess) { fprintf(stderr, "kernel_launch: hipFuncSetAttribute failed\n"); grid = -1; return; }
        if (hipOccupancyMaxActiveBlocksPerMultiprocessor(&per_cu, (const void*)fwd_kernel, NTHR, LDS_BYTES) != hipSuccess || per_cu < 1) { fprintf(stderr, "kernel_launch: occupancy query says %d\n", per_cu); per_cu = 1; }
        (void)hipGetLastError();
        grid = cus * (per_cu > 1 ? 1 : per_cu);
        fprintf(stderr, "kernel_launch: grid %d (cus %d, per_cu %d)\n", grid, cus, per_cu);
    }
    if (grid < 0) return;
    Params p{};
    for (int i = 0; i < 31; ++i) p.in[i] = (const float*)d_in[i];
    p.out = (float*)d_out; p.ws = (unsigned char*)d_ws;
#if N_LAUNCH_SPLIT
    for (int ph = 0; ph < 13; ++ph) { p.ph_lo = ph; p.ph_hi = ph + 1; hipLaunchKernelGGL(fwd_kernel, dim3(grid), dim3(NTHR), LDS_BYTES, stream, p); }
#else
    p.ph_lo = 0; p.ph_hi = 13;
    void* args[] = {&p};
    hipError_t e = hipLaunchCooperativeKernel((const void*)fwd_kernel, dim3(grid), dim3(NTHR), args, LDS_BYTES, stream);
    if (e != hipSuccess) fprintf(stderr, "kernel_launch: cooperative launch failed: %s (grid %d)\n", hipGetErrorString(e), grid);
#endif
}
```

```cpp
#include <hip/hip_runtime.h>
#include <hip/hip_cooperative_groups.h>
#include <cstdio>
#include <cstdint>
namespace cg = cooperative_groups;
namespace pg8 {
#define PG8_LAS __attribute__((address_space(3)))
typedef unsigned short bf16_t;
typedef short bf16x8 __attribute__((ext_vector_type(8)));
typedef float f32x4 __attribute__((ext_vector_type(4)));
typedef unsigned u32x4 __attribute__((ext_vector_type(4)));
constexpr int BM = 256, BK = 64, HALF = 128, HTB = HALF * BK * 2  , STAGE_BYTES = 8 * HTB, NXCD = 8, WGM = 8;

__host__ __device__ __forceinline__ int lds_byte(int r, int c) { const int st = (r >> 4) * 2 + (c >> 5), rr = r & 15, cc = c & 31, ob = rr * 64 + cc * 2; return st * 1024 + (ob ^ (((ob >> 9) & 1) << 5)); }
__host__ __device__ __forceinline__ void stage_rc(int b, int& R, int& C) { const int st = b / 1024, sb = b % 1024, swz = sb ^ (((sb >> 9) & 1) << 5); R = (st >> 1) * 16 + swz / 64; C = (st & 1) * 32 + (swz % 64) / 2; }
__host__ __device__ __forceinline__ int perm32(int rho) { const int n = rho >> 4, i = rho & 15; return 8 * (i >> 2) + 4 * n + (i & 3); }

struct Unit { int pm, pn; };
struct Gemm { const bf16_t* A; const bf16_t* Bt; int M, N, K; };

struct StaticOrder {
    int nM, nN, nwg, G, c;
    __host__ __device__ void init(int M, int N, int G_, int c_) { nM = M / BM; nN = N / BM; nwg = nM * nN; G = G_; c = c_; }
    __host__ __device__ bool next(int i, Unit& u) const {
        const long L = (long)i * G + c; if (L >= nwg) return false;
        int wgid = (int)L; { const int q = nwg / NXCD, r = nwg % NXCD, xcd = wgid % NXCD, off = wgid / NXCD; wgid = (xcd < r ? xcd * (q + 1) : r * (q + 1) + (xcd - r) * q) + off; }
        const int nig = WGM * nN, gid = wgid / nig, fm = gid * WGM, gsz = (nM - fm) < WGM ? (nM - fm) : WGM;
        u.pm = fm + ((wgid % nig) % gsz); u.pn = (wgid % nig) / gsz; return true;
    }
    __device__ __forceinline__ void a_ready(const Unit&) const {}
    __device__ __forceinline__ void done(const Unit&) const {}
};

template <class Epi, class Sched, bool ALIGN_EPI = false, bool SP2 = false>
__device__ __forceinline__ void gemm_phase(PG8_LAS unsigned char* lds, const Gemm g, const Sched& S, const Epi& E) {
    int tid_ = threadIdx.x; asm volatile("" : "+v"(tid_)); const int tid = tid_, wid = __builtin_amdgcn_readfirstlane(tid >> 6), lane = tid & 63, wr = wid >> 2, wc = wid & 3, fr = lane & 15, fq = lane >> 4;
    const int K = g.K, nt = K / BK;
    unsigned voffA[2], voffB[2];
#pragma unroll
    for (int i = 0; i < 2; ++i) { int R, C; stage_rc(tid * 16 + i * 8192, R, C); const int Rb = Epi::PERM ? ((R & ~31) + perm32(R & 31)) : R;
        voffA[i] = (unsigned)(R * K + C) * 2u; voffB[i] = (unsigned)(Rb * K + C) * 2u; }
    const size_t kstep = (size_t)(BK * 2);
    const size_t hstep = (size_t)HALF * K * 2;
    const size_t tstep = 2 * hstep;
    const unsigned ldsw = (unsigned)wid * 1024u;
    const int aoff = lds_byte(wr * 64 + fr, fq * 8), boff = lds_byte(wc * 32 + fr, fq * 8);
#define PG8_SA(b, h) (((b) * 2 + (h)) * HTB)
#define PG8_SB(b, h) ((4 + (b) * 2 + (h)) * HTB)
#define PG8_STAGE(bufoff, gbase, voff) do { _Pragma("unroll") for (int _i = 0; _i < 2; ++_i) \
        __builtin_amdgcn_global_load_lds((const unsigned*)((const char*)(gbase) + (voff)[_i]), (PG8_LAS unsigned*)(lds + (bufoff) + ldsw + _i * 8192), 16, 0, 0); } while (0)
#define PG8_LDA(dst, b, h) do { _Pragma("unroll") for (int m = 0; m < 4; ++m) _Pragma("unroll") for (int k = 0; k < 2; ++k) dst[m][k] = *(const PG8_LAS bf16x8*)(lds + PG8_SA(b, h) + aoff + m * 2048 + k * 1024); } while (0)
#define PG8_LDB(dst, b, h) do { _Pragma("unroll") for (int n = 0; n < 2; ++n) _Pragma("unroll") for (int k = 0; k < 2; ++k) dst[n][k] = *(const PG8_LAS bf16x8*)(lds + PG8_SB(b, h) + boff + n * 2048 + k * 1024); } while (0)
#define PG8_MMA(ai, bj, At, Bt) do { __builtin_amdgcn_s_setprio(1); _Pragma("unroll") for (int m = 0; m < 4; ++m) _Pragma("unroll") for (int n = 0; n < 2; ++n) _Pragma("unroll") for (int k = 0; k < 2; ++k) \
        acc[ai][bj][m][n] = __builtin_amdgcn_mfma_f32_16x16x32_bf16(Bt[n][k], At[m][k], acc[ai][bj][m][n], 0, 0, 0); __builtin_amdgcn_s_setprio(0); } while (0)
#define PG8_WAIT_V(n) asm volatile("s_waitcnt vmcnt(" #n ")" ::: "memory")
#define PG8_WAIT_L(n) asm volatile("s_waitcnt lgkmcnt(" #n ")" ::: "memory")
#define PG8_BAR __builtin_amdgcn_s_barrier()
#define PG8_SCHED __builtin_amdgcn_sched_barrier(0)
    Unit cur, nxt; int ui = 0;
    if (!S.next(0, cur)) return;
    f32x4 acc[2][2][4][2];
#pragma unroll
    for (int a = 0; a < 2; ++a)
#pragma unroll
        for (int b = 0; b < 2; ++b)
#pragma unroll
            for (int m = 0; m < 4; ++m)
#pragma unroll
                for (int n = 0; n < 2; ++n) acc[a][b][m][n] = (f32x4){0.f, 0.f, 0.f, 0.f};
    bf16x8 At[4][2], B0[2][2], B1[2][2];
    const char* cA = (const char*)g.A + (size_t)cur.pm * tstep; const char* cB = (const char*)g.Bt + (size_t)cur.pn * tstep;
    S.a_ready(cur);
    if constexpr (SP2) {
        PG8_STAGE(PG8_SB(0, 0), cB, voffB); PG8_STAGE(PG8_SB(0, 1), cB + hstep, voffB); PG8_STAGE(PG8_SA(0, 0), cA, voffA); PG8_STAGE(PG8_SA(0, 1), cA + hstep, voffA);
        if (wr == 1) PG8_BAR;
        PG8_WAIT_V(2); PG8_BAR;
        PG8_STAGE(PG8_SB(1, 0), cB + kstep, voffB); PG8_STAGE(PG8_SA(1, 0), cA + kstep, voffA); PG8_STAGE(PG8_SB(1, 1), cB + hstep + kstep, voffB);
        PG8_WAIT_V(6); PG8_BAR;
    } else {
        PG8_STAGE(PG8_SB(0, 0), cB, voffB); PG8_STAGE(PG8_SA(0, 0), cA, voffA); PG8_STAGE(PG8_SB(0, 1), cB + hstep, voffB); PG8_STAGE(PG8_SA(0, 1), cA + hstep, voffA);
        if (wr == 1) PG8_BAR;
        PG8_WAIT_V(4); PG8_BAR;
        PG8_STAGE(PG8_SB(1, 0), cB + kstep, voffB); PG8_STAGE(PG8_SA(1, 0), cA + kstep, voffA); PG8_STAGE(PG8_SB(1, 1), cB + hstep + kstep, voffB);
        PG8_WAIT_V(6); PG8_BAR;
    }
    for (;;) {
        const bool has_next = S.next(ui + 1, nxt);
        const char* nA = has_next ? (const char*)g.A + (size_t)nxt.pm * tstep : cA; const char* nB = has_next ? (const char*)g.Bt + (size_t)nxt.pn * tstep : cB;
        for (int t = 0; t < nt; t += 2) {
            const bool last = (t == nt - 2);
            const char* a1 = cA + (size_t)(t + 1) * kstep;
            const char* a2 = last ? nA : cA + (size_t)(t + 2) * kstep; const char* b2 = last ? nB : cB + (size_t)(t + 2) * kstep;
            const char* a3 = a2 + kstep; const char* b3 = b2 + kstep;
            if (last && has_next) S.a_ready(nxt);
            if constexpr (SP2) {
            PG8_LDB(B0, 0, 0); PG8_LDB(B1, 0, 1); PG8_SCHED; PG8_LDA(At, 0, 0); PG8_STAGE(PG8_SA(1, 1), a1 + hstep, voffA);
            PG8_WAIT_V(8); PG8_WAIT_L(0); PG8_BAR; PG8_MMA(0, 0, At, B0); PG8_MMA(0, 1, At, B1); PG8_BAR; PG8_SCHED;
            PG8_LDA(At, 0, 1); PG8_STAGE(PG8_SB(0, 0), b2, voffB); PG8_STAGE(PG8_SB(0, 1), b2 + hstep, voffB); PG8_STAGE(PG8_SA(0, 0), a2, voffA);
            PG8_WAIT_V(8); PG8_WAIT_L(0); PG8_BAR; PG8_MMA(1, 0, At, B0); PG8_MMA(1, 1, At, B1); PG8_BAR; PG8_SCHED;
            PG8_LDB(B0, 1, 0); PG8_LDB(B1, 1, 1); PG8_SCHED; PG8_LDA(At, 1, 0); PG8_STAGE(PG8_SA(0, 1), a2 + hstep, voffA);
            PG8_WAIT_V(8); PG8_WAIT_L(0); PG8_BAR; PG8_MMA(0, 0, At, B0); PG8_MMA(0, 1, At, B1); PG8_BAR; PG8_SCHED;
            PG8_LDA(At, 1, 1); PG8_STAGE(PG8_SB(1, 0), b3, voffB); PG8_STAGE(PG8_SB(1, 1), b3 + hstep, voffB); PG8_STAGE(PG8_SA(1, 0), a3, voffA);
            PG8_WAIT_V(8); PG8_WAIT_L(0); PG8_BAR; PG8_MMA(1, 0, At, B0); PG8_MMA(1, 1, At, B1); PG8_BAR; PG8_SCHED;
            } else {
            PG8_LDB(B0, 0, 0); PG8_SCHED; PG8_LDA(At, 0, 0); PG8_STAGE(PG8_SA(1, 1), a1 + hstep, voffA);
            PG8_WAIT_L(8); PG8_BAR; PG8_WAIT_L(0); PG8_MMA(0, 0, At, B0); PG8_BAR; PG8_SCHED;
            PG8_LDB(B1, 0, 1); PG8_STAGE(PG8_SB(0, 0), b2, voffB);
            PG8_BAR; PG8_WAIT_L(0); PG8_MMA(0, 1, At, B1); PG8_BAR;
            PG8_LDA(At, 0, 1); PG8_STAGE(PG8_SA(0, 0), a2, voffA);
            PG8_BAR; PG8_WAIT_L(0); PG8_MMA(1, 0, At, B0); PG8_BAR; PG8_SCHED;
            PG8_STAGE(PG8_SB(0, 1), b2 + hstep, voffB);
            PG8_WAIT_V(6); PG8_BAR; PG8_MMA(1, 1, At, B1); PG8_BAR;
            PG8_LDB(B0, 1, 0); PG8_SCHED; PG8_LDA(At, 1, 0); PG8_STAGE(PG8_SA(0, 1), a2 + hstep, voffA);
            PG8_WAIT_L(8); PG8_BAR; PG8_WAIT_L(0); PG8_MMA(0, 0, At, B0); PG8_BAR; PG8_SCHED;
            PG8_LDB(B1, 1, 1); PG8_STAGE(PG8_SB(1, 0), b3, voffB);
            PG8_BAR; PG8_WAIT_L(0); PG8_MMA(0, 1, At, B1); PG8_BAR;
            PG8_LDA(At, 1, 1); PG8_STAGE(PG8_SA(1, 0), a3, voffA);
            PG8_BAR; PG8_WAIT_L(0); PG8_MMA(1, 0, At, B0); PG8_BAR; PG8_SCHED;
            PG8_STAGE(PG8_SB(1, 1), b3 + hstep, voffB);
            PG8_WAIT_V(6); PG8_BAR; PG8_MMA(1, 1, At, B1); PG8_BAR;
            }
        }
        if constexpr (ALIGN_EPI) { if (wr == 0) PG8_BAR; }
        if constexpr (!Epi::AFTER_DRAIN) { E(acc, cur, wr, wc, fr, fq); S.done(cur); }
        if (!has_next) break;
#pragma unroll
        for (int a = 0; a < 2; ++a)
#pragma unroll
            for (int b = 0; b < 2; ++b)
#pragma unroll
                for (int m = 0; m < 4; ++m)
#pragma unroll
                    for (int n = 0; n < 2; ++n) acc[a][b][m][n] = (f32x4){0.f, 0.f, 0.f, 0.f};
        cur = nxt; cA = nA; cB = nB; ++ui;
        if constexpr (ALIGN_EPI) { if (wr == 1) PG8_BAR; }
    }
    PG8_WAIT_V(0);
    if constexpr (!ALIGN_EPI) { if (wr == 0) PG8_BAR; }
    PG8_BAR;
    if constexpr (Epi::AFTER_DRAIN) { E.fused(acc, cur, wr, wc, fr, fq, lds, wid, lane); S.done(cur); }
#undef PG8_SA
#undef PG8_SB
#undef PG8_STAGE
#undef PG8_LDA
#undef PG8_LDB
#undef PG8_MMA
#undef PG8_WAIT_V
#undef PG8_WAIT_L
#undef PG8_BAR
#undef PG8_SCHED
}
}

#define LAS __attribute__((address_space(3)))
typedef unsigned short bf16_t;
typedef short bf16x8 __attribute__((ext_vector_type(8)));
typedef short s16x4 __attribute__((ext_vector_type(4)));
typedef float f32x4 __attribute__((ext_vector_type(4)));
typedef float f32x2 __attribute__((ext_vector_type(2)));
typedef float f32x16 __attribute__((ext_vector_type(16)));
typedef unsigned u32x4 __attribute__((ext_vector_type(4)));
typedef unsigned u32x2 __attribute__((ext_vector_type(2)));
typedef __bf16 bf16x2_t __attribute__((ext_vector_type(2)));

constexpr int MP = 65536, MS = 512, MT = MP + MS, PAST = 2048, SKV = 2112, KVR = MP + 8 * SKV;
constexpr float EPS = 1e-6f, LOG2E = 1.4426950408889634f;
constexpr float QS_FOX = 0.125f * LOG2E, QS_MLA = 0.10206207261596575f * LOG2E, QS_MEM = 0.08838834764831845f * LOG2E;
constexpr int NTHR = 512;

constexpr size_t OFF_Y = 0;
constexpr size_t OFF_P_FOX_K = (size_t)MT * 1024;
constexpr size_t OFF_P_FOX_V = OFF_P_FOX_K + (size_t)MP * 512;
constexpr size_t OFF_P_LOGF = OFF_P_FOX_V + (size_t)MP * 512;
constexpr size_t OFF_P_CKV = OFF_P_LOGF + (size_t)MP * 8;
constexpr size_t OFF_P_KR = OFF_P_CKV + (size_t)MP * 256;
constexpr size_t OFF_P_MEM_K = OFF_P_KR + (size_t)MP * 32;
constexpr size_t OFF_P_MEM_V = OFF_P_MEM_K + (size_t)4096 * 512;
constexpr size_t OFF_S_FOX_K = OFF_P_MEM_V + (size_t)4096 * 512;
constexpr size_t OFF_S_FOX_V = OFF_S_FOX_K + (size_t)MS * 512;
constexpr size_t OFF_S_LOGF = OFF_S_FOX_V + (size_t)MS * 512;
constexpr size_t OFF_S_CKV = OFF_S_LOGF + (size_t)MS * 8;
constexpr size_t OFF_S_KR = OFF_S_CKV + (size_t)MS * 256;
constexpr size_t OUT_TOTAL = OFF_S_KR + (size_t)MS * 32;
static_assert(OUT_TOTAL == 159010816ull, "d_out map");

constexpr size_t MiB = 1u << 20;
constexpr size_t WS_W_IN = 0, WS_W_UQ = 5 * MiB, WS_W_UKV = 6 * MiB, WS_W_O = 7 * MiB, WS_W_MKV = 9 * MiB, WS_W_MQ = 11 * MiB, WS_W_MO = 12 * MiB,
                 WS_W_GU = 13 * MiB, WS_W_D = 24 * MiB, WS_ROPE = 30 * MiB, WS_SSQ = 31 * MiB, WS_CUM = 33 * MiB, WS_MEMK = 36 * MiB, WS_MEMV = 42 * MiB,
                 WS_MN = 48 * MiB, WS_XN = 56 * MiB  , WS_D = 185 * MiB;
constexpr size_t WS_ZS = WS_D, WS_QF = 282 * MiB, WS_KF = 347 * MiB, WS_VF = 428 * MiB, WS_CQR = 509 * MiB, WS_CKVB = 558 * MiB, WS_KRB = 599 * MiB,
                 WS_MQ = 605 * MiB, WS_MKN = 702 * MiB, WS_MV = 783 * MiB, WS_END = 864 * MiB;
constexpr size_t WS_CTL = 32 * MiB + 512 * 1024, CTL_BYTES = 16384;
constexpr size_t WS_XB = WS_D, WS_CQ = 314 * MiB, WS_CO = 379 * MiB, WS_H = 444 * MiB;
static_assert(WS_H + (size_t)MT * 2816 * 2 <= WS_END, "H overlay");
static_assert(WS_ZS + (size_t)MT * 384 * 4 <= WS_QF && WS_QF + (size_t)MT * 512 * 2 <= WS_KF && WS_KF + (size_t)KVR * 512 * 2 <= WS_VF && WS_VF + (size_t)KVR * 512 * 2 <= WS_CQR, "map1");
static_assert(WS_CQR + (size_t)MT * 384 * 2 <= WS_CKVB && WS_CKVB + (size_t)KVR * 256 * 2 <= WS_KRB && WS_KRB + (size_t)KVR * 32 * 2 <= WS_MQ && WS_MQ + (size_t)MT * 768 * 2 <= WS_MKN, "map2");
static_assert(WS_MKN + (size_t)KVR * 512 * 2 <= WS_MV && WS_MV + (size_t)KVR * 512 * 2 <= WS_END && WS_XN + (size_t)MT * 1024 * 2 <= WS_D, "map3");
static_assert(WS_XB + (size_t)MT * 1024 * 2 <= WS_CQ && WS_CQ + (size_t)MT * 512 * 2 <= WS_CO && WS_CO + (size_t)MT * 512 * 2 <= WS_H, "map4");

struct Params { const float* in[31]; float* out; unsigned char* ws; int ph_lo, ph_hi; };

__device__ __forceinline__ unsigned pk2(float lo, float hi) { f32x2 v = {lo, hi}; bf16x2_t b = __builtin_convertvector(v, bf16x2_t); return __builtin_bit_cast(unsigned, b); }
__device__ __forceinline__ u32x2 pk4(f32x4 v) { return (u32x2){pk2(v[0], v[1]), pk2(v[2], v[3])}; }
__device__ __forceinline__ float dot4(f32x4 v) { return (v[0] * v[0] + v[1] * v[1]) + (v[2] * v[2] + v[3] * v[3]); }
__device__ __forceinline__ float wave_sum(float v) {
#pragma unroll
    for (int o = 1; o < 64; o <<= 1) v += __shfl_xor(v, o);
    return v;
}
__device__ __forceinline__ int kvrow(int r) { return r < MP ? r : MP + ((r - MP) >> 6) * SKV + PAST + ((r - MP) & 63); }
__device__ __forceinline__ int rowpos(int r) { return r < MP ? (r & 4095) : PAST + ((r - MP) & 63); }
#define LDS_WAIT() asm volatile("s_waitcnt lgkmcnt(0)" ::: "memory")

__constant__ double ROPE_INV[16] = {1.0, 0.5623413251903491, 0.31622776601683794, 0.1778279410038923, 0.1, 0.05623413251903491, 0.031622776601683794, 0.01778279410038923,
                                    0.01, 0.005623413251903491, 0.0031622776601683794, 0.001778279410038923, 0.001, 0.0005623413251903491, 0.00031622776601683794, 0.0001778279410038923};

#define EPI_ARGS const pg8::f32x4 (&acc)[2][2][4][2], const pg8::Unit& u, int wr, int wc, int fr, int fq
#define FOR_AI_M _Pragma("unroll") for (int ai = 0; ai < 2; ++ai) _Pragma("unroll") for (int m = 0; m < 4; ++m)
#define FOR_BJ_N _Pragma("unroll") for (int bj = 0; bj < 2; ++bj) _Pragma("unroll") for (int n = 0; n < 2; ++n)

struct Epi1 {
    static constexpr bool PERM = false, AFTER_DRAIN = false;
    bf16_t *QF, *KF, *VF, *CQR; float *ZS, *SSQQ, *out;
    __device__ __forceinline__ void operator()(EPI_ARGS) const {
        const int pn = u.pn, row0 = u.pm * 256 + wr * 64 + fr, cw = wc * 32 + 4 * fq; const bool samp = u.pm >= 256;
        if (pn < 2) {
            FOR_AI_M { const int row = row0 + ai * 128 + m * 16; bf16_t* p = QF + (size_t)row * 512 + pn * 256 + cw;
                FOR_BJ_N { const f32x4 v = acc[ai][bj][m][n] * QS_FOX; *(u32x2*)(p + bj * 128 + n * 16) = pk4(v); } }
        } else if (pn < 6) {
            const bool isV = pn >= 4; bf16_t* B = isV ? VF : KF;
            float* O = out + (samp ? (isV ? OFF_S_FOX_V : OFF_S_FOX_K) : (isV ? OFF_P_FOX_V : OFF_P_FOX_K));
            const int cb = (pn & 1) * 256 + cw;
            FOR_AI_M { const int row = row0 + ai * 128 + m * 16, orow = samp ? row - MP : row, kr = kvrow(row);
                float* po = O + (size_t)orow * 512 + cb; bf16_t* pb = B + (size_t)kr * 512 + cb;
                FOR_BJ_N { const f32x4 v = acc[ai][bj][m][n]; *(f32x4*)(po + bj * 128 + n * 16) = v; *(u32x2*)(pb + bj * 128 + n * 16) = pk4(v); } }
        } else {
            FOR_AI_M { const int row = row0 + ai * 128 + m * 16; float ss = 0.f;
#pragma unroll
                for (int bj = 0; bj < 2; ++bj) { const int gc = pn * 256 + bj * 128;
                    if (gc < 1920) { bf16_t* p = CQR + (size_t)row * 384 + (gc - 1536) + cw;
#pragma unroll
                        for (int n = 0; n < 2; ++n) { const f32x4 v = acc[ai][bj][m][n]; *(u32x2*)(p + n * 16) = pk4(v); ss += dot4(v); } }
                    else { float* p = ZS + (size_t)row * 384 + (gc - 1920) + cw;
#pragma unroll
                        for (int n = 0; n < 2; ++n) *(f32x4*)(p + n * 16) = acc[ai][bj][m][n]; } }
                if (pn * 256 < 1920) { ss += __shfl_xor(ss, 16); ss += __shfl_xor(ss, 32); if (fq == 0) unsafeAtomicAdd(SSQQ + row, ss); } }
        }
    }
};
struct EpiM {
    static constexpr bool PERM = false, AFTER_DRAIN = false;
    bf16_t *MEMK, *MEMV; float* out;
    __device__ __forceinline__ void operator()(EPI_ARGS) const {
        const bool isV = u.pn >= 2; bf16_t* B = isV ? MEMV : MEMK; float* O = out + (isV ? OFF_P_MEM_V : OFF_P_MEM_K);
        const int row0 = u.pm * 256 + wr * 64 + fr, cb = (u.pn & 1) * 256 + wc * 32 + 4 * fq;
        FOR_AI_M { const int row = row0 + ai * 128 + m * 16; float* po = O + (size_t)row * 512 + cb; bf16_t* pb = B + (size_t)row * 512 + cb;
            FOR_BJ_N { const f32x4 v = acc[ai][bj][m][n]; *(f32x4*)(po + bj * 128 + n * 16) = v; *(u32x2*)(pb + bj * 128 + n * 16) = pk4(v); } }
    }
};
struct Epi3 {
    static constexpr bool PERM = false, AFTER_DRAIN = false;
    bf16_t *MKN, *MV;
    __device__ __forceinline__ void operator()(EPI_ARGS) const {
        bf16_t* B = (wc >= 2) ? MV : MKN; const int cw = (wc & 1) * 32 + 4 * fq, row0 = u.pm * 256 + wr * 64 + fr;
        FOR_AI_M { const int row = row0 + ai * 128 + m * 16;
            FOR_BJ_N { bf16_t* p = B + (size_t)row * 512 + (2 * u.pn + bj) * 64 + cw + n * 16; *(u32x2*)p = pk4(acc[ai][bj][m][n]); } }
    }
};
template <bool XB_OUT> struct EpiRes {
    static constexpr bool PERM = false, AFTER_DRAIN = false;
    const float *bp, *bs; float* Y; bf16_t* XB; float* SSQ;
    __device__ __forceinline__ void operator()(EPI_ARGS) const {
        const int row0 = u.pm * 256 + wr * 64 + fr, cb = u.pn * 256 + wc * 32 + 4 * fq;
        FOR_AI_M { const int row = row0 + ai * 128 + m * 16;
            const float* b = (u.pm >= 256) ? bs + (size_t)(row - MP) * 1024 : bp + (size_t)row * 1024; float* y = Y + (size_t)row * 1024; float ss = 0.f;
            FOR_BJ_N { const int off = cb + bj * 128 + n * 16; const f32x4 v = acc[ai][bj][m][n] + *(const f32x4*)(b + off); *(f32x4*)(y + off) = v;
                if (XB_OUT) *(u32x2*)(XB + (size_t)row * 1024 + off) = pk4(v); ss += dot4(v); }
            ss += __shfl_xor(ss, 16); ss += __shfl_xor(ss, 32); if (fq == 0) unsafeAtomicAdd(SSQ + row, ss);
            asm volatile("" ::: "memory"); }
    }
};
struct EpiScale {
    static constexpr bool PERM = false, AFTER_DRAIN = false;
    bf16_t* O; int ldo; const float* SSQ; float inv_n, qs;
    __device__ __forceinline__ void operator()(EPI_ARGS) const {
        const int row0 = u.pm * 256 + wr * 64 + fr, cb = u.pn * 256 + wc * 32 + 4 * fq;
        FOR_AI_M { const int row = row0 + ai * 128 + m * 16; const float rs = rsqrtf(SSQ[row] * inv_n + EPS) * qs; bf16_t* p = O + (size_t)row * ldo + cb;
            FOR_BJ_N { *(u32x2*)(p + bj * 128 + n * 16) = pk4(acc[ai][bj][m][n] * rs); } }
    }
};
struct EpiGLU {
    static constexpr bool PERM = false, AFTER_DRAIN = false;
    bf16_t* H; const float* SSQ;
    __device__ __forceinline__ void operator()(EPI_ARGS) const {
        const int row0 = u.pm * 256 + wr * 64 + fr, cb = u.pn * 128 + wc * 32 + 4 * fq;
        FOR_AI_M { const int row = row0 + ai * 128 + m * 16; const float rs = rsqrtf(SSQ[row] * (1.0f / 1024.0f) + EPS); bf16_t* p = H + (size_t)row * 2816 + cb;
#pragma unroll
            for (int n = 0; n < 2; ++n) { const f32x4 g = acc[ai][0][m][n] * rs, uu = acc[ai][1][m][n] * rs; f32x4 h;
#pragma unroll
                for (int e = 0; e < 4; ++e) h[e] = g[e] * uu[e] * __builtin_amdgcn_rcpf(1.0f + __builtin_amdgcn_exp2f(-g[e] * LOG2E));
                *(u32x2*)(p + n * 16) = pk4(h); } }
    }
};

struct AttnUnit {
    const bf16_t* Q; int ldq;
    const bf16_t* K; int ldk;
    const bf16_t* K2;
    const bf16_t* V; int ldv;
    const float* CK;
    const float* ROPE;
    bf16_t* O; int ldo;
    int nrows, qpos0, NT;
};
__device__ __forceinline__ int crow(int r, int hi) { return (r & 3) + 8 * (r >> 2) + 4 * hi; }
__device__ __forceinline__ s16x4 vtr(const LAS unsigned char* p) {
    typedef short v4i16_t __attribute__((ext_vector_type(4)));
    return __builtin_bit_cast(s16x4, __builtin_amdgcn_ds_read_tr16_b64_v4i16((LAS v4i16_t*)p));
}
template <int DK, int DV, int MODE>
__device__ __forceinline__ void attn_unit(const AttnUnit& d, LAS unsigned char* lds) {
    constexpr int DKM = (MODE == 1) ? 64 : DK;
    constexpr int KS = DK * 2 + 16;
    constexpr int NKC = DKM / 64, NVC = DV / 64, VSUB = DV / 32, CPRK = DKM / 8, CPRV = DV / 8;
    constexpr int KB0 = 0, KBS = 17408, VB0 = 34816, VBS = 16384, CKO = 67584;
    int tid_ = threadIdx.x; asm volatile("" : "+v"(tid_)); const int tid = tid_, lane = tid & 63, wid = __builtin_amdgcn_readfirstlane(tid >> 6), r32 = lane & 31, hi = lane >> 5;
    const bool wact = (wid * 32 < d.nrows);
    const int qpw = d.qpos0 + wid * 32;
    int tmax = (MODE == 0) ? ((qpw + 31) >> 6) : (MODE == 1) ? (qpw >> 6) : (d.NT - 1);
    if (!wact) tmax = -1;
    const int NT = d.NT;
    bf16x8 qf[DK / 16];
    {
        const bf16_t* qp = d.Q + (size_t)((wact ? wid * 32 : 0) + r32) * d.ldq + hi * 8;
#pragma unroll
        for (int ks = 0; ks < DK / 16; ++ks) qf[ks] = *(const bf16x8*)(qp + ks * 16);
    }
    if (MODE == 1) {
        const int pos = (wact ? qpw : d.qpos0) + r32; const float* cp = d.ROPE + pos * 16 + hi * 8;
        const f32x4 c0 = *(const f32x4*)cp, c1 = *(const f32x4*)(cp + 4), s0 = *(const f32x4*)(cp + 65536), s1 = *(const f32x4*)(cp + 65540);
        const u32x4 a = __builtin_bit_cast(u32x4, qf[4]), b = __builtin_bit_cast(u32x4, qf[5]); u32x4 oa, ob;
#pragma unroll
        for (int k = 0; k < 4; ++k) {
            const float x1l = __uint_as_float(a[k] << 16), x1h = __uint_as_float(a[k] & 0xffff0000u), x2l = __uint_as_float(b[k] << 16), x2h = __uint_as_float(b[k] & 0xffff0000u);
            const float cl = (k < 2) ? c0[2 * k] : c1[2 * k - 4], ch = (k < 2) ? c0[2 * k + 1] : c1[2 * k - 3], sl = (k < 2) ? s0[2 * k] : s1[2 * k - 4], sh = (k < 2) ? s0[2 * k + 1] : s1[2 * k - 3];
            oa[k] = pk2(x1l * cl - x2l * sl, x1h * ch - x2h * sh); ob[k] = pk2(x2l * cl + x1l * sl, x2h * ch + x1h * sh);
        }
        qf[4] = __builtin_bit_cast(bf16x8, oa); qf[5] = __builtin_bit_cast(bf16x8, ob);
    }
    float cq = 0.f;
    if (MODE == 0) cq = d.CK[(size_t)((wact ? qpw : d.qpos0) + r32) * 8];
    u32x4 kreg[NKC], vreg[NVC], k2reg = (u32x4){0u, 0u, 0u, 0u}; float ckreg = 0.f;
#define ATT_LOAD(t) do { \
        _Pragma("unroll") for (int i_ = 0; i_ < NKC; ++i_) { const int id_ = tid + 512 * i_, row_ = id_ / CPRK, c_ = id_ % CPRK; \
            kreg[i_] = *(const u32x4*)(d.K + (size_t)((t) * 64 + row_) * d.ldk + c_ * 8); } \
        _Pragma("unroll") for (int i_ = 0; i_ < NVC; ++i_) { const int id_ = tid + 512 * i_, row_ = id_ / CPRV, c_ = id_ % CPRV; \
            vreg[i_] = *(const u32x4*)(d.V + (size_t)((t) * 64 + row_) * d.ldv + c_ * 8); } \
        if (MODE == 1) { if (tid < 256) k2reg = *(const u32x4*)(d.K2 + (size_t)((t) * 64 + (tid >> 2)) * 32 + (tid & 3) * 8); } \
        if (MODE == 0) { if (tid < 64) ckreg = d.CK[(size_t)((t) * 64 + tid) * 8]; } } while (0)
#define ATT_STORE(buf) do { \
        _Pragma("unroll") for (int i_ = 0; i_ < NKC; ++i_) { const int id_ = tid + 512 * i_, row_ = id_ / CPRK, c_ = id_ % CPRK; \
            *(LAS u32x4*)(lds + KB0 + (buf) * KBS + row_ * KS + c_ * 16) = kreg[i_]; } \
        _Pragma("unroll") for (int i_ = 0; i_ < NVC; ++i_) { const int id_ = tid + 512 * i_, row_ = id_ / CPRV, c_ = id_ % CPRV; \
            *(LAS u32x4*)(lds + VB0 + (buf) * VBS + ((row_ >> 3) * VSUB + (c_ >> 2)) * 512 + (row_ & 7) * 64 + (c_ & 3) * 16) = vreg[i_]; } \
        if (MODE == 1) { if (tid < 256) *(LAS u32x4*)(lds + KB0 + (buf) * KBS + (tid >> 2) * KS + 128 + (tid & 3) * 16) = k2reg; } \
        if (MODE == 0) { if (tid < 64) *(LAS float*)(lds + CKO + (buf) * 256 + tid * 4) = ckreg; } } while (0)
    f32x16 o[VSUB];
#pragma unroll
    for (int db = 0; db < VSUB; ++db)
#pragma unroll
        for (int i = 0; i < 16; ++i) o[db][i] = 0.f;
    float mrun = -1e30f, lrun = 0.f;
    ATT_LOAD(0); ATT_STORE(0); __syncthreads();
    for (int t = 0; t < NT; ++t) {
        const int buf = t & 1;
        if (t + 1 < NT) ATT_LOAD(t + 1);
        if (t <= tmax) {
            f32x16 s[2];
#pragma unroll
            for (int sb = 0; sb < 2; ++sb) {
                f32x16 c;
#pragma unroll
                for (int i = 0; i < 16; ++i) c[i] = 0.f;
                const LAS unsigned char* kp = lds + KB0 + buf * KBS + (sb * 32 + r32) * KS + hi * 16;
#pragma unroll
                for (int ks = 0; ks < DK / 16; ++ks) { const bf16x8 a = *(const LAS bf16x8*)(kp + ks * 32); c = __builtin_amdgcn_mfma_f32_32x32x16_bf16(a, qf[ks], c, 0, 0, 0); }
                s[sb] = c;
            }
            if (MODE == 0) {
#pragma unroll
                for (int sb = 0; sb < 2; ++sb)
#pragma unroll
                    for (int g = 0; g < 4; ++g) { const f32x4 ck = *(const LAS f32x4*)(lds + CKO + buf * 256 + (sb * 32 + 8 * g + 4 * hi) * 4);
#pragma unroll
                        for (int e = 0; e < 4; ++e) s[sb][4 * g + e] += cq - ck[e]; }
                if (t * 64 + 63 > qpw) {
                    const int qp = qpw + r32;
#pragma unroll
                    for (int sb = 0; sb < 2; ++sb)
#pragma unroll
                        for (int i = 0; i < 16; ++i) { const int kvp = t * 64 + sb * 32 + crow(i, hi); if (kvp > qp) s[sb][i] = -1e30f; }
                }
            }
            float mx = s[0][0];
#pragma unroll
            for (int i = 1; i < 16; ++i) mx = fmaxf(mx, s[0][i]);
#pragma unroll
            for (int i = 0; i < 16; ++i) mx = fmaxf(mx, s[1][i]);
            mx = fmaxf(mx, __shfl_xor(mx, 32));
            const float mnew = fmaxf(mrun, mx), alpha = __builtin_amdgcn_exp2f(mrun - mnew); mrun = mnew;
            float ps = 0.f;
#pragma unroll
            for (int sb = 0; sb < 2; ++sb)
#pragma unroll
                for (int i = 0; i < 16; ++i) { const float p = __builtin_amdgcn_exp2f(s[sb][i] - mnew); s[sb][i] = p; ps += p; }
            lrun = lrun * alpha + ps;
#pragma unroll
            for (int db = 0; db < VSUB; ++db)
#pragma unroll
                for (int i = 0; i < 16; ++i) o[db][i] *= alpha;
            bf16x8 pf[4];
#pragma unroll
            for (int st = 0; st < 4; ++st) { const int sb = st >> 1, b8 = (st & 1) * 8;
                u32x4 w; w[0] = pk2(s[sb][b8 + 0], s[sb][b8 + 1]); w[1] = pk2(s[sb][b8 + 2], s[sb][b8 + 3]); w[2] = pk2(s[sb][b8 + 4], s[sb][b8 + 5]); w[3] = pk2(s[sb][b8 + 6], s[sb][b8 + 7]);
                pf[st] = __builtin_bit_cast(bf16x8, w); }
            const LAS unsigned char* vp = lds + VB0 + buf * VBS + (4 * hi + ((lane & 15) >> 2)) * 64 + ((lane >> 4) & 1) * 32 + (lane & 3) * 8;
#pragma unroll
            for (int db = 0; db < VSUB; ++db)
#pragma unroll
                for (int st = 0; st < 4; ++st) {
                    const s16x4 lo = vtr(vp + ((2 * st) * VSUB + db) * 512), hh = vtr(vp + ((2 * st + 1) * VSUB + db) * 512);
                    const bf16x8 vf = __builtin_shufflevector(lo, hh, 0, 1, 2, 3, 4, 5, 6, 7);
                    o[db] = __builtin_amdgcn_mfma_f32_32x32x16_bf16(vf, pf[st], o[db], 0, 0, 0);
                }
        }
        if (t + 1 < NT) ATT_STORE(buf ^ 1);
        __syncthreads();
    }
    if (wact) {
        const float lt = lrun + __shfl_xor(lrun, 32), inv = 1.0f / lt;
        bf16_t* op = d.O + (size_t)(wid * 32 + r32) * d.ldo + 4 * hi;
#pragma unroll
        for (int db = 0; db < VSUB; ++db)
#pragma unroll
            for (int g = 0; g < 4; ++g) { const f32x4 v = (f32x4){o[db][4 * g], o[db][4 * g + 1], o[db][4 * g + 2], o[db][4 * g + 3]} * inv; *(u32x2*)(op + db * 32 + 8 * g) = pk4(v); }
    }
#undef ATT_LOAD
#undef ATT_STORE
}

__device__ __forceinline__ void transpose_item(const float* __restrict__ W, int ldw, int srccol0, int nvalid, const float* __restrict__ gk,
                                               bf16_t* WT, int K, int dstrow0, int k0, LAS float* scr, int lane) {
#pragma unroll 8
    for (int i = 0; i < 32; ++i) { const int kk = 2 * i + (lane >> 5), n = lane & 31; float v = 0.f;
        if (n < nvalid) { v = W[(size_t)(k0 + kk) * ldw + srccol0 + n]; if (gk) v *= gk[k0 + kk]; }
        scr[kk * 33 + n] = v; }
    LDS_WAIT();
    const int c = lane & 7;
#pragma unroll
    for (int j = 0; j < 4; ++j) { const int n = (lane >> 3) + 8 * j; const LAS float* s = scr + (8 * c) * 33 + n;
        u32x4 o; o.x = pk2(s[0 * 33], s[1 * 33]); o.y = pk2(s[2 * 33], s[3 * 33]); o.z = pk2(s[4 * 33], s[5 * 33]); o.w = pk2(s[6 * 33], s[7 * 33]);
        *(u32x4*)(WT + (size_t)(dstrow0 + n) * K + k0 + 8 * c) = o; }
    LDS_WAIT();
}
__device__ __forceinline__ void rms_rows4_to_bf16(const float* xrow, const float* g, bf16_t* orow, int lane) {
    f32x4 v[16]; float s[4];
#pragma unroll
    for (int j = 0; j < 16; ++j) v[j] = ((const f32x4*)xrow)[lane + 64 * j];
#pragma unroll
    for (int k = 0; k < 4; ++k) { s[k] = (dot4(v[4 * k]) + dot4(v[4 * k + 1])) + (dot4(v[4 * k + 2]) + dot4(v[4 * k + 3])); }
#pragma unroll
    for (int k = 0; k < 4; ++k) s[k] = rsqrtf(wave_sum(s[k]) * (1.0f / 1024.0f) + EPS);
#pragma unroll
    for (int j = 0; j < 16; ++j) { const f32x4 gg = ((const f32x4*)g)[lane + 64 * (j & 3)]; ((u32x2*)orow)[lane + 64 * j] = pk4(v[j] * s[j >> 2] * gg); }
}
__device__ __forceinline__ void cvt_rows(const float* src, bf16_t* dst, int nrows, int W8, int rpg, int drow0, int dstride, size_t gtid, size_t gthreads) {
    const size_t total = (size_t)nrows * W8;
    for (size_t idx = gtid; idx < total; idx += gthreads) {
        const int row = (int)(idx / W8), c8 = (int)(idx % W8), drow = drow0 + (row / rpg) * dstride + (row % rpg);
        const f32x4 a = *(const f32x4*)(src + idx * 8), b = *(const f32x4*)(src + idx * 8 + 4);
        *(u32x4*)(dst + ((size_t)drow * W8 + c8) * 8) = (u32x4){pk2(a[0], a[1]), pk2(a[2], a[3]), pk2(b[0], b[1]), pk2(b[2], b[3])};
    }
}

#define XB_TMO      128
#define XB_XCNT(j)  (256  + 64 * (j))
#define XB_XSUB(j)  (1280 + 64 * (j))
#define XB_XGEN(j)  (2304 + 64 * (j))
#define XB_TOP      3328
#define XB_TOPGEN   3392
#define XCD_BAR_WORDS 3456
#define XB_SPIN_CAP (1u << 18)

__device__ __forceinline__ unsigned xb_ld(unsigned* p)              { return __hip_atomic_load(p, __ATOMIC_RELAXED, __HIP_MEMORY_SCOPE_AGENT); }
__device__ __forceinline__ unsigned xb_add(unsigned* p, unsigned v) { return __hip_atomic_fetch_add(p, v, __ATOMIC_RELAXED, __HIP_MEMORY_SCOPE_AGENT); }
__device__ __forceinline__ unsigned xb_xcc_id() { return (unsigned)__builtin_amdgcn_s_getreg((3 << 11) | 20) & 0xFu; }
#define XB_SPIN(cond, bar) do { unsigned _sp = 0; while (cond) { __builtin_amdgcn_s_sleep(1); \
    if ((++_sp & 255u) == 0u) { if (xb_ld(&(bar)[XB_TMO])) break; if (_sp > XB_SPIN_CAP) { atomicAdd(&(bar)[XB_TMO], 1u); break; } } } } while (0)

struct XcdBarrier {
    unsigned* bar; unsigned x;
    volatile LAS unsigned* st;
};

__device__ __forceinline__ XcdBarrier xcd_barrier_post(unsigned* bar, volatile LAS unsigned* st) {
    XcdBarrier b; b.bar = bar; b.x = xb_xcc_id(); b.st = st;
    if (threadIdx.x == 0) (void)xb_add(&bar[XB_XCNT(b.x)], 1u);
    return b;
}
__device__ __forceinline__ void xcd_barrier_complete(unsigned* bar, unsigned x, unsigned& nloc, unsigned& nx) {
    const unsigned G = gridDim.x * gridDim.y * gridDim.z;
    unsigned sum, cnt, mine, sp = 0u;
    for (;;) {
        sum = 0u; cnt = 0u; mine = 0u;
#pragma unroll
        for (unsigned j = 0; j < 16; ++j) { const unsigned c = xb_ld(&bar[XB_XCNT(j)]); sum += c; cnt += (c > 0u) ? 1u : 0u; mine = (j == x) ? c : mine; }
        if (sum == G) break;
        __builtin_amdgcn_s_sleep(1);
        if ((++sp & 255u) == 0u) { if (xb_ld(&bar[XB_TMO])) break; if (sp > XB_SPIN_CAP) { atomicAdd(&bar[XB_TMO], 1u); break; } }
    }
    nloc = mine > 0u ? mine : 1u; nx = cnt > 0u ? cnt : 1u;
}

__device__ __forceinline__ void xcd_barrier(const XcdBarrier& b) {
    asm volatile("s_waitcnt vmcnt(0)" ::: "memory");
    __syncthreads();
    if (threadIdx.x == 0) {
        unsigned* bar = b.bar;
        __builtin_amdgcn_s_waitcnt(0);
        unsigned nloc = b.st[0], nx = b.st[1];
        if (nloc == 0u) { xcd_barrier_complete(bar, b.x, nloc, nx); b.st[0] = nloc; b.st[1] = nx; }
        const unsigned old = xb_add(&bar[XB_XSUB(b.x)], 1u);
        const unsigned gen = old / nloc;
        if (old + 1u == (gen + 1u) * nloc) {
            __builtin_amdgcn_fence(__ATOMIC_RELEASE, "agent");
            asm volatile("s_waitcnt vmcnt(0)" ::: "memory");
            const unsigned og = xb_add(&bar[XB_TOP], 1u);
            const unsigned tg = og / nx;
            if (og + 1u == (tg + 1u) * nx) xb_add(&bar[XB_TOPGEN], 1u);
            else XB_SPIN(xb_ld(&bar[XB_TOPGEN]) == tg, bar);
            __builtin_amdgcn_fence(__ATOMIC_ACQUIRE, "agent");
            xb_add(&bar[XB_XGEN(b.x)], 1u);
            asm volatile("s_waitcnt vmcnt(0)" ::: "memory");
        } else {
            XB_SPIN(xb_ld(&bar[XB_XGEN(b.x)]) == gen, bar);
            __builtin_amdgcn_fence(__ATOMIC_ACQUIRE, "agent");
            asm volatile("s_waitcnt vmcnt(0)" ::: "memory");
        }
    }
    __syncthreads();
}

constexpr int LDS_BYTES = 135168;
__global__ void __launch_bounds__(NTHR, 2) fwd_kernel(Params P) {
    extern __shared__ __attribute__((aligned(16))) unsigned char lds_raw[];
    LAS unsigned char* lds = (LAS unsigned char*)lds_raw;
    cg::grid_group grid = cg::this_grid();
    if (threadIdx.x < 64) ((LAS unsigned*)(lds + 131072))[threadIdx.x] = 0u;
    __syncthreads();
    XcdBarrier xbar = xcd_barrier_post((unsigned*)(P.ws + WS_CTL), (volatile LAS unsigned*)(lds + 131072) + 8);
    const int wid = __builtin_amdgcn_readfirstlane(threadIdx.x >> 6);
    const int G = gridDim.x, bx = blockIdx.x;
#define FRESH_TID() int tid_ = threadIdx.x; asm volatile("" : "+v"(tid_)); const int tid = tid_, lane = tid & 63; (void)lane; const size_t gtid = (size_t)bx * NTHR + tid; (void)gtid
    const int vcu = (G % 8 == 0) ? (bx % 8) * (G / 8) + bx / 8 : bx;
    const int gw = bx * 8 + wid, NGW = G * 8;
    const size_t gthreads = (size_t)G * NTHR;
    unsigned char* ws = P.ws; float* out = P.out;
    bf16_t *W_IN = (bf16_t*)(ws + WS_W_IN), *W_UQ = (bf16_t*)(ws + WS_W_UQ), *W_UKV = (bf16_t*)(ws + WS_W_UKV), *W_O = (bf16_t*)(ws + WS_W_O), *W_MKV = (bf16_t*)(ws + WS_W_MKV),
           *W_MQ = (bf16_t*)(ws + WS_W_MQ), *W_MO = (bf16_t*)(ws + WS_W_MO), *W_GU = (bf16_t*)(ws + WS_W_GU), *W_D = (bf16_t*)(ws + WS_W_D);
    float *COS = (float*)(ws + WS_ROPE), *SIN = COS + 4096 * 16;
    float *SSQQ = (float*)(ws + WS_SSQ), *SSQ1 = SSQQ + MT, *SSQ2 = SSQ1 + MT, *SSQ3 = SSQ2 + MT;
    float* CUM = (float*)(ws + WS_CUM);
    bf16_t *MEMK = (bf16_t*)(ws + WS_MEMK), *MEMV = (bf16_t*)(ws + WS_MEMV), *MN = (bf16_t*)(ws + WS_MN), *XN = (bf16_t*)(ws + WS_XN), *ATT = XN;
    float* ZS = (float*)(ws + WS_ZS);
    bf16_t *QF = (bf16_t*)(ws + WS_QF), *KF = (bf16_t*)(ws + WS_KF), *VF = (bf16_t*)(ws + WS_VF), *CQR = (bf16_t*)(ws + WS_CQR), *CKVB = (bf16_t*)(ws + WS_CKVB), *KRB = (bf16_t*)(ws + WS_KRB),
           *MQ = (bf16_t*)(ws + WS_MQ), *MKN = (bf16_t*)(ws + WS_MKN), *MV = (bf16_t*)(ws + WS_MV);
    bf16_t *XB = (bf16_t*)(ws + WS_XB), *CQ = (bf16_t*)(ws + WS_CQ), *CO = (bf16_t*)(ws + WS_CO), *HB = (bf16_t*)(ws + WS_H);
    const int lo = P.ph_lo, hi_ph = P.ph_hi;
#ifndef PHASE_MASK
#define PHASE_MASK 0x1fff
#endif
#define IN(k) (((PHASE_MASK >> (k)) & 1) && lo <= (k) && (k) < hi_ph)
#define SEAM(k) do { if (IN(k) && IN((k) + 1)) { if (P.ph_lo < 0) grid.sync(); else xcd_barrier(xbar); } } while (0)

    if (IN(0)) {
        FRESH_TID();
        for (size_t i = gtid; i < (size_t)4 * MT; i += gthreads) SSQQ[i] = 0.f;
        for (size_t i = gtid; i < (size_t)4096 * 16; i += gthreads) {
            const int pos = (int)(i >> 4), j = (int)(i & 15); const double a = (double)pos * ROPE_INV[j] * 0.15915494309189535; const float fr_ = (float)(a - floor(a));
            COS[i] = __builtin_amdgcn_cosf(fr_); SIN[i] = __builtin_amdgcn_sinf(fr_);
        }
        {
            LAS float* scr = (LAS float*)(lds + wid * 16384);
            constexpr int I1 = 16 * 72, I2 = 6 * 24, I3 = 4 * 32, I4 = 16 * 32, I5 = 16 * 32, I6 = 16 * 16, I7 = 8 * 32, I8 = 16 * 176, I9 = 44 * 32;
            constexpr int NIT = I1 + I2 + I3 + I4 + I5 + I6 + I7 + I8 + I9;
            for (int it = gw; it < NIT; it += NGW) {
                int r = it;
                if (r < I1) { const int kb = r / 72, nb = r % 72, n0 = nb * 32; int src, nv;
                    if (n0 < 1536) { src = n0; nv = 32; } else if (n0 < 2208) { src = n0 + 8; nv = 32; } else if (n0 == 2208) { src = 1536; nv = 8; } else { src = 0; nv = 0; }
                    transpose_item(P.in[11], 2216, src, nv, nullptr, W_IN, 1024, n0, kb * 64, scr, lane); continue; } r -= I1;
                if (r < I2) { const int kb = r / 24, nb = r % 24; transpose_item(P.in[14], 768, nb * 32, 32, P.in[13], W_UQ, 384, nb * 32, kb * 64, scr, lane); continue; } r -= I2;
                if (r < I3) { const int kb = r / 32, nb = r % 32; transpose_item(P.in[16], 1024, nb * 32, 32, nullptr, W_UKV, 256, nb * 32, kb * 64, scr, lane); continue; } r -= I3;
                if (r < I4) { const int kb = r / 32, nb = r % 32; transpose_item(P.in[19], 1024, nb * 32, 32, nullptr, W_O, 1024, nb * 32, kb * 64, scr, lane); continue; } r -= I4;
                if (r < I5) { const int kb = r / 32, nb = r % 32; transpose_item(nb < 16 ? P.in[21] : P.in[22], 512, (nb & 15) * 32, 32, nullptr, W_MKV, 1024, nb * 32, kb * 64, scr, lane); continue; } r -= I5;
                if (r < I6) { const int kb = r / 16, nb = r % 16; transpose_item(P.in[24], 512, nb * 32, 32, P.in[23], W_MQ, 1024, nb * 32, kb * 64, scr, lane); continue; } r -= I6;
                if (r < I7) { const int kb = r / 32, nb = r % 32; transpose_item(P.in[25], 1024, nb * 32, 32, nullptr, W_MO, 512, nb * 32, kb * 64, scr, lane); continue; } r -= I7;
                if (r < I8) { const int kb = r / 176, nb = r % 176, tile = nb >> 3, j = nb & 7;
                    transpose_item(j < 4 ? P.in[27] : P.in[28], 2816, tile * 128 + (j & 3) * 32, 32, P.in[26], W_GU, 1024, nb * 32, kb * 64, scr, lane); continue; } r -= I8;
                { const int kb = r / 32, nb = r % 32; transpose_item(P.in[29], 1024, nb * 32, 32, nullptr, W_D, 2816, nb * 32, kb * 64, scr, lane); }
            }
        }
        for (int m = gw * 4; m < MT; m += NGW * 4) rms_rows4_to_bf16(m < MP ? P.in[0] + (size_t)m * 1024 : P.in[1] + (size_t)(m - MP) * 1024, P.in[10], XN + (size_t)m * 1024, lane);
        for (int m = gw * 4; m < 4096; m += NGW * 4) rms_rows4_to_bf16(P.in[2] + (size_t)m * 1024, P.in[20], MN + (size_t)m * 1024, lane);
        cvt_rows(P.in[3], KF, 16384, 64, 2048, MP, SKV, gtid, gthreads);
        cvt_rows(P.in[4], VF, 16384, 64, 2048, MP, SKV, gtid, gthreads);
        cvt_rows(P.in[6], CKVB, 16384, 32, 2048, MP, SKV, gtid, gthreads);
        cvt_rows(P.in[7], KRB, 16384, 4, 2048, MP, SKV, gtid, gthreads);
        cvt_rows(P.in[8], MEMK, 2048, 64, 2048, 4096, 0, gtid, gthreads);
        cvt_rows(P.in[9], MEMV, 2048, 64, 2048, 4096, 0, gtid, gthreads);
    }
    SEAM(0);
    if (IN(1)) {
        { pg8::Gemm g{XN, W_IN, MT, 2304, 1024}; pg8::StaticOrder S; S.init(MT, 2304, G, bx); Epi1 E{QF, KF, VF, CQR, ZS, SSQQ, out};
          pg8::gemm_phase<Epi1, pg8::StaticOrder, true, true>(lds, g, S, E); }
        { pg8::Gemm g{MN, W_MKV, 4096, 1024, 1024}; pg8::StaticOrder S; S.init(4096, 1024, G, (bx + 64) % G); EpiM E{MEMK, MEMV, out};
          pg8::gemm_phase<EpiM, pg8::StaticOrder, true, true>(lds, g, S, E); }
    }
    SEAM(1);
    if (IN(2)) {
        FRESH_TID();
        for (int r0 = gw * 4; r0 < MT; r0 += NGW * 4) {
            f32x4 v[4]; float x1[4], x2[4], fz[4];
#pragma unroll
            for (int k = 0; k < 4; ++k) { const float* z = ZS + (size_t)(r0 + k) * 384; v[k] = *(const f32x4*)(z + 4 * lane); x1[k] = 0.f; x2[k] = 0.f; fz[k] = 0.f;
                if (lane < 16) { x1[k] = z[256 + lane]; x2[k] = z[272 + lane]; } if (lane < 8) fz[k] = z[288 + lane]; }
            const f32x4 gkv = *(const f32x4*)(P.in[15] + 4 * lane); const float bf = (lane < 8) ? P.in[12][lane] : 0.f;
            float rs[4];
#pragma unroll
            for (int k = 0; k < 4; ++k) rs[k] = dot4(v[k]);
#pragma unroll
            for (int k = 0; k < 4; ++k) rs[k] = rsqrtf(wave_sum(rs[k]) * (1.0f / 256.0f) + EPS);
#pragma unroll
            for (int k = 0; k < 4; ++k) { const int r = r0 + k; const bool samp = r >= MP; const int orow = samp ? r - MP : r, kr = kvrow(r);
                const f32x4 ov = v[k] * rs[k] * gkv;
                *(f32x4*)(out + (samp ? OFF_S_CKV : OFF_P_CKV) + (size_t)orow * 256 + 4 * lane) = ov;
                *(u32x2*)(CKVB + (size_t)kr * 256 + 4 * lane) = pk4(ov);
                if (lane < 16) { const int pos = rowpos(r); const float c = COS[pos * 16 + lane], sn = SIN[pos * 16 + lane];
                    const float o1 = x1[k] * c - x2[k] * sn, o2 = x2[k] * c + x1[k] * sn; float* po = out + (samp ? OFF_S_KR : OFF_P_KR) + (size_t)orow * 32;
                    po[lane] = o1; po[lane + 16] = o2; bf16_t* pb = KRB + (size_t)kr * 32; pb[lane] = (bf16_t)(pk2(o1, 0.f) & 0xffffu); pb[lane + 16] = (bf16_t)(pk2(o2, 0.f) & 0xffffu); }
                if (lane < 8) { const float f = fz[k] + bf; const float lf = fminf(f, 0.f) - log1pf(__expf(-fabsf(f)));
                    out[(samp ? OFF_S_LOGF : OFF_P_LOGF) + (size_t)orow * 8 + lane] = lf; } }
        }
    }
    SEAM(2);
    if (IN(3)) {
        FRESH_TID();
        for (int job = bx; job < 24; job += G) {
            LAS float* TS = (LAS float*)lds; const bool samp = job >= 16; const int sb = job - 16, nthr = samp ? 264 : 512;
            const float* src; if (!samp) src = out + OFF_P_LOGF + ((size_t)job * 4096 + tid * 8) * 8; else if (tid < 256) src = P.in[5] + ((size_t)sb * 2048 + tid * 8) * 8; else src = out + OFF_S_LOGF + ((size_t)sb * 64 + (tid - 256) * 8) * 8;
            float s[8];
#pragma unroll
            for (int k = 0; k < 8; ++k) s[k] = 0.f;
            if (tid < nthr) {
#pragma unroll
                for (int r = 0; r < 8; ++r) { const f32x4 a = *(const f32x4*)(src + r * 8), b = *(const f32x4*)(src + r * 8 + 4);
                    s[0] += a[0]; s[1] += a[1]; s[2] += a[2]; s[3] += a[3]; s[4] += b[0]; s[5] += b[1]; s[6] += b[2]; s[7] += b[3]; }
            }
#pragma unroll
            for (int k = 0; k < 8; ++k) TS[tid * 8 + k] = s[k];
            __syncthreads();
            { float part = 0.f, loc[8];
#pragma unroll
                for (int k = 0; k < 8; ++k) { loc[k] = part; part += TS[(lane * 8 + k) * 8 + wid]; }
                float inc = part;
#pragma unroll
                for (int o = 1; o < 64; o <<= 1) { const float t = __shfl_up(inc, o); if (lane >= o) inc += t; }
                const float exc = inc - part;
#pragma unroll
                for (int k = 0; k < 8; ++k) TS[(lane * 8 + k) * 8 + wid] = exc + loc[k]; }
            __syncthreads();
            if (tid < nthr) {
#pragma unroll
                for (int k = 0; k < 8; ++k) s[k] = TS[tid * 8 + k];
                float* dst = CUM + ((size_t)(samp ? MP + sb * SKV : job * 4096) + tid * 8) * 8;
#pragma unroll
                for (int r = 0; r < 8; ++r) { const f32x4 a = *(const f32x4*)(src + r * 8), b = *(const f32x4*)(src + r * 8 + 4);
                    s[0] += a[0]; s[1] += a[1]; s[2] += a[2]; s[3] += a[3]; s[4] += b[0]; s[5] += b[1]; s[6] += b[2]; s[7] += b[3];
                    *(f32x4*)(dst + r * 8) = (f32x4){s[0], s[1], s[2], s[3]} * LOG2E; *(f32x4*)(dst + r * 8 + 4) = (f32x4){s[4], s[5], s[6], s[7]} * LOG2E; }
            }
            __syncthreads();
        }
        { pg8::Gemm g{CQR, W_UQ, MT, 768, 384}; pg8::StaticOrder S; S.init(MT, 768, G, bx); EpiScale E{MQ, 768, SSQQ, 1.0f / 384.0f, QS_MLA};
          pg8::gemm_phase<EpiScale, pg8::StaticOrder, true, true>(lds, g, S, E); }
        { pg8::Gemm g{CKVB, W_UKV, KVR, 1024, 256}; pg8::StaticOrder S; S.init(KVR, 1024, G, bx); Epi3 E{MKN, MV};
          pg8::gemm_phase<Epi3, pg8::StaticOrder, true, true>(lds, g, S, E); }
    }
    SEAM(3);
    if (IN(4)) {
        for (int uu = vcu; uu < 4224; uu += G) {
            AttnUnit d; bool mla; d.ROPE = COS;
            if (uu < 4096) {
                mla = uu >= 2048; const int u2 = uu & 2047, i = u2 >> 8, c = u2 & 255, bh = c >> 1, b = bh >> 3, h = bh & 7, qb = 2 * i + ((i & 1) ^ (c & 1));
                const size_t seq0 = (size_t)b * 4096, q0 = seq0 + qb * 256;
                d.nrows = 256; d.qpos0 = qb * 256; d.NT = (qb + 1) * 4;
                if (!mla) { d.Q = QF + q0 * 512 + h * 64; d.ldq = 512; d.K = KF + seq0 * 512 + h * 64; d.ldk = 512; d.K2 = nullptr; d.V = VF + seq0 * 512 + h * 64; d.ldv = 512; d.CK = CUM + seq0 * 8 + h; d.O = ATT + q0 * 1024 + h * 64; d.ldo = 1024; }
                else { d.Q = MQ + q0 * 768 + h * 96; d.ldq = 768; d.K = MKN + seq0 * 512 + h * 64; d.ldk = 512; d.K2 = KRB + seq0 * 32; d.V = MV + seq0 * 512 + h * 64; d.ldv = 512; d.CK = nullptr; d.O = ATT + q0 * 1024 + 512 + h * 64; d.ldo = 1024; }
            } else {
                const int u2 = uu - 4096; mla = u2 >= 64; const int sb = (u2 & 63) >> 3, h = u2 & 7;
                const size_t seq0 = (size_t)MP + (size_t)sb * SKV, q0 = (size_t)MP + sb * 64;
                d.nrows = 64; d.qpos0 = PAST; d.NT = 33;
                if (!mla) { d.Q = QF + q0 * 512 + h * 64; d.ldq = 512; d.K = KF + seq0 * 512 + h * 64; d.ldk = 512; d.K2 = nullptr; d.V = VF + seq0 * 512 + h * 64; d.ldv = 512; d.CK = CUM + seq0 * 8 + h; d.O = ATT + q0 * 1024 + h * 64; d.ldo = 1024; }
                else { d.Q = MQ + q0 * 768 + h * 96; d.ldq = 768; d.K = MKN + seq0 * 512 + h * 64; d.ldk = 512; d.K2 = KRB + seq0 * 32; d.V = MV + seq0 * 512 + h * 64; d.ldv = 512; d.CK = nullptr; d.O = ATT + q0 * 1024 + 512 + h * 64; d.ldo = 1024; }
            }
            if (!mla) attn_unit<64, 64, 0>(d, lds); else attn_unit<96, 64, 1>(d, lds);
        }
    }
    SEAM(4);
    if (IN(5)) {
        FRESH_TID();
        for (int r0 = gw * 4; r0 < MT; r0 += NGW * 4) {
            bf16_t* a = ATT + (size_t)r0 * 1024; u32x4 w[8];
#pragma unroll
            for (int q = 0; q < 8; ++q) w[q] = *(const u32x4*)(a + (q >> 1) * 1024 + (q & 1) * 512 + lane * 8);
            float ss[8];
#pragma unroll
            for (int q = 0; q < 8; ++q) { float t = 0.f;
#pragma unroll
                for (int k = 0; k < 4; ++k) { const float xl = __uint_as_float(w[q][k] << 16), xh = __uint_as_float(w[q][k] & 0xffff0000u); t += xl * xl + xh * xh; }
                ss[q] = t; }
#pragma unroll
            for (int q = 0; q < 8; ++q) ss[q] = rsqrtf(wave_sum(ss[q]) * (1.0f / 512.0f) + EPS);
#pragma unroll
            for (int q = 0; q < 8; ++q) { const float* g = P.in[17 + (q & 1)] + lane * 8; const f32x4 g0 = *(const f32x4*)g, g1 = *(const f32x4*)(g + 4); const float rstd = ss[q]; float x[8];
#pragma unroll
                for (int k = 0; k < 4; ++k) { x[2 * k] = __uint_as_float(w[q][k] << 16); x[2 * k + 1] = __uint_as_float(w[q][k] & 0xffff0000u); }
                *(u32x4*)(a + (q >> 1) * 1024 + (q & 1) * 512 + lane * 8) = (u32x4){pk2(x[0] * rstd * g0[0], x[1] * rstd * g0[1]), pk2(x[2] * rstd * g0[2], x[3] * rstd * g0[3]),
                                                                                    pk2(x[4] * rstd * g1[0], x[5] * rstd * g1[1]), pk2(x[6] * rstd * g1[2], x[7] * rstd * g1[3])}; }
        }
    }
    SEAM(5);
    if (IN(6)) {
        pg8::Gemm g{ATT, W_O, MT, 1024, 1024}; pg8::StaticOrder S; S.init(MT, 1024, G, bx); EpiRes<true> E{P.in[0], P.in[1], out, XB, SSQ1};
        pg8::gemm_phase<EpiRes<true>, pg8::StaticOrder, true, true>(lds, g, S, E);
    }
    SEAM(6);
    if (IN(7)) {
        pg8::Gemm g{XB, W_MQ, MT, 512, 1024}; pg8::StaticOrder S; S.init(MT, 512, G, bx); EpiScale E{CQ, 512, SSQ1, 1.0f / 1024.0f, QS_MEM};
        pg8::gemm_phase<EpiScale, pg8::StaticOrder, true, true>(lds, g, S, E);
    }
    SEAM(7);
    if (IN(8)) {
        for (int uu = vcu; uu < 1024 + 32; uu += G) {
            AttnUnit d; d.ROPE = nullptr; d.K2 = nullptr; d.CK = nullptr; d.qpos0 = 0; d.NT = 4; d.ldq = 512; d.ldk = 512; d.ldv = 512; d.ldo = 512;
            if (uu < 1024) { const int rb = uu >> 2, h = uu & 3, b = rb >> 4; const size_t q0 = (size_t)rb * 256;
                d.nrows = 256; d.Q = CQ + q0 * 512 + h * 128; d.O = CO + q0 * 512 + h * 128; d.K = MEMK + (size_t)b * 256 * 512 + h * 128; d.V = MEMV + (size_t)b * 256 * 512 + h * 128; }
            else { const int u2 = uu - 1024, sb = u2 >> 2, h = u2 & 3; const size_t q0 = (size_t)MP + sb * 64;
                d.nrows = 64; d.Q = CQ + q0 * 512 + h * 128; d.O = CO + q0 * 512 + h * 128; d.K = MEMK + (size_t)(16 + sb) * 256 * 512 + h * 128; d.V = MEMV + (size_t)(16 + sb) * 256 * 512 + h * 128; }
            attn_unit<128, 128, 2>(d, lds);
        }
    }
    SEAM(8);
    if (IN(9)) {
        pg8::Gemm g{CO, W_MO, MT, 1024, 512}; pg8::StaticOrder S; S.init(MT, 1024, G, bx); EpiRes<true> E{out, out + (size_t)MP * 1024, out, XB, SSQ2};
        pg8::gemm_phase<EpiRes<true>, pg8::StaticOrder, true, true>(lds, g, S, E);
    }
    SEAM(9);
    if (IN(10)) {
        pg8::Gemm g{XB, W_GU, MT, 5632, 1024}; pg8::StaticOrder S; S.init(MT, 5632, G, bx); EpiGLU E{HB, SSQ2};
        pg8::gemm_phase<EpiGLU, pg8::StaticOrder, true, true>(lds, g, S, E);
    }
    SEAM(10);
    if (IN(11)) {
        pg8::Gemm g{HB, W_D, MT, 1024, 2816}; pg8::StaticOrder S; S.init(MT, 1024, G, bx); EpiRes<false> E{out, out + (size_t)MP * 1024, out, nullptr, SSQ3};
        pg8::gemm_phase<EpiRes<false>, pg8::StaticOrder, true, true>(lds, g, S, E);
    }
    SEAM(11);
    if (IN(12)) {
        FRESH_TID();
        for (int r0 = gw * 4; r0 < MT; r0 += NGW * 4) {
            float* y = out + (size_t)r0 * 1024; f32x4 v[16]; float rstd[4];
#pragma unroll
            for (int j = 0; j < 16; ++j) v[j] = ((const f32x4*)y)[lane + 64 * j];
#pragma unroll
            for (int k = 0; k < 4; ++k) rstd[k] = rsqrtf(SSQ3[r0 + k] * (1.0f / 1024.0f) + EPS);
#pragma unroll
            for (int j = 0; j < 16; ++j) { const f32x4 gg = ((const f32x4*)P.in[30])[lane + 64 * (j & 3)]; ((f32x4*)y)[lane + 64 * j] = v[j] * rstd[j >> 2] * gg; }
        }
    }
#undef IN
#undef SEAM
}

#ifndef N_LAUNCH_SPLIT
#define N_LAUNCH_SPLIT 0
#endif
extern "C" void kernel_launch(void* const* d_in, const int* in_sizes, int n_in, void* d_out, int out_size, void* d_ws, size_t ws_size, hipStream_t stream) {
    static int grid = 0;
    if (grid == 0) {
        if (n_in != 31 || (size_t)out_size != OUT_TOTAL || ws_size < WS_END) { fprintf(stderr, "kernel_launch: unexpected shapes: n_in %d out %d ws %zu\n", n_in, out_size, ws_size); grid = -1; return; }
        int dev = 0, cus = 0, per_cu = 0;
        hipGetDevice(&dev); hipDeviceGetAttribute(&cus, hipDeviceAttributeMultiprocessorCount, dev);
        if (hipFuncSetAttribute((const void*)fwd_kernel, hipFuncAttributeMaxDynamicSharedMemorySize, LDS_BYTES) != hipSuccess) { fprintf(stderr, "kernel_launch: hipFuncSetAttribute failed\n"); grid = -1; return; }
        if (hipOccupancyMaxActiveBlocksPerMultiprocessor(&per_cu, (const void*)fwd_kernel, NTHR, LDS_BYTES) != hipSuccess || per_cu < 1) { fprintf(stderr, "kernel_launch: occupancy query says %d\n", per_cu); per_cu = 1; }
        (void)hipGetLastError();
        grid = cus * (per_cu > 1 ? 1 : per_cu);
        fprintf(stderr, "kernel_launch: grid %d (cus %d, per_cu %d)\n", grid, cus, per_cu);
    }
    if (grid < 0) return;
    Params p{};
    for (int i = 0; i < 31; ++i) p.in[i] = (const float*)d_in[i];
    p.out = (float*)d_out; p.ws = (unsigned char*)d_ws;
#if N_LAUNCH_SPLIT
    for (int ph = 0; ph < 13; ++ph) { p.ph_lo = ph; p.ph_hi = ph + 1; hipLaunchKernelGGL(fwd_kernel, dim3(grid), dim3(NTHR), LDS_BYTES, stream, p); }
#else
    p.ph_lo = 0; p.ph_hi = 13;
    if (hipMemsetAsync((char*)d_ws + WS_CTL, 0, CTL_BYTES, stream) != hipSuccess) { fprintf(stderr, "kernel_launch: memset failed\n"); return; }
    void* args[] = {&p};
    hipError_t e = hipLaunchCooperativeKernel((const void*)fwd_kernel, dim3(grid), dim3(NTHR), args, LDS_BYTES, stream);
    if (e != hipSuccess) fprintf(stderr, "kernel_launch: cooperative launch failed: %s (grid %d)\n", hipGetErrorString(e), grid);
#endif
}
```

```cpp
#include <hip/hip_runtime.h>
#include <hip/hip_cooperative_groups.h>
#include <cstdio>
#include <cstdint>
namespace cg = cooperative_groups;
namespace pg8 {
#define PG8_LAS __attribute__((address_space(3)))
typedef unsigned short bf16_t;
typedef short bf16x8 __attribute__((ext_vector_type(8)));
typedef float f32x4 __attribute__((ext_vector_type(4)));
typedef unsigned u32x4 __attribute__((ext_vector_type(4)));
constexpr int BM = 256, BK = 64, HALF = 128, HTB = HALF * BK * 2  , STAGE_BYTES = 8 * HTB, NXCD = 8, WGM = 8;

__host__ __device__ __forceinline__ int lds_byte(int r, int c) { const int st = (r >> 4) * 2 + (c >> 5), rr = r & 15, cc = c & 31, ob = rr * 64 + cc * 2; return st * 1024 + (ob ^ (((ob >> 9) & 1) << 5)); }
__host__ __device__ __forceinline__ void stage_rc(int b, int& R, int& C) { const int st = b / 1024, sb = b % 1024, swz = sb ^ (((sb >> 9) & 1) << 5); R = (st >> 1) * 16 + swz / 64; C = (st & 1) * 32 + (swz % 64) / 2; }
__host__ __device__ __forceinline__ int perm32(int rho) { const int n = rho >> 4, i = rho & 15; return 8 * (i >> 2) + 4 * n + (i & 3); }

struct Unit { int pm, pn; };
struct Gemm { const bf16_t* A; const bf16_t* Bt; int M, N, K; };

struct StaticOrder {
    int nM, nN, nwg, G, c;
    __host__ __device__ void init(int M, int N, int G_, int c_) { nM = M / BM; nN = N / BM; nwg = nM * nN; G = G_; c = c_; }
    __host__ __device__ bool next(int i, Unit& u) const {
        const long L = (long)i * G + c; if (L >= nwg) return false;
        int wgid = (int)L; { const int q = nwg / NXCD, r = nwg % NXCD, xcd = wgid % NXCD, off = wgid / NXCD; wgid = (xcd < r ? xcd * (q + 1) : r * (q + 1) + (xcd - r) * q) + off; }
        const int nig = WGM * nN, gid = wgid / nig, fm = gid * WGM, gsz = (nM - fm) < WGM ? (nM - fm) : WGM;
        u.pm = fm + ((wgid % nig) % gsz); u.pn = (wgid % nig) / gsz; return true;
    }
    __device__ __forceinline__ void a_ready(const Unit&) const {}
    __device__ __forceinline__ void done(const Unit&) const {}
};

template <class Epi, class Sched, bool ALIGN_EPI = false, bool SP2 = false>
__device__ __forceinline__ void gemm_phase(PG8_LAS unsigned char* lds, const Gemm g, const Sched& S, const Epi& E) {
    int tid_ = threadIdx.x; asm volatile("" : "+v"(tid_)); const int tid = tid_, wid = __builtin_amdgcn_readfirstlane(tid >> 6), lane = tid & 63, wr = wid >> 2, wc = wid & 3, fr = lane & 15, fq = lane >> 4;
    const int K = g.K, nt = K / BK;
    unsigned voffA[2], voffB[2];
#pragma unroll
    for (int i = 0; i < 2; ++i) { int R, C; stage_rc(tid * 16 + i * 8192, R, C); const int Rb = Epi::PERM ? ((R & ~31) + perm32(R & 31)) : R;
        voffA[i] = (unsigned)(R * K + C) * 2u; voffB[i] = (unsigned)(Rb * K + C) * 2u; }
    const size_t kstep = (size_t)(BK * 2);
    const size_t hstep = (size_t)HALF * K * 2;
    const size_t tstep = 2 * hstep;
    const unsigned ldsw = (unsigned)wid * 1024u;
    const int aoff = lds_byte(wr * 64 + fr, fq * 8), boff = lds_byte(wc * 32 + fr, fq * 8);
#define PG8_SA(b, h) (((b) * 2 + (h)) * HTB)
#define PG8_SB(b, h) ((4 + (b) * 2 + (h)) * HTB)
#define PG8_STAGE(bufoff, gbase, voff) do { _Pragma("unroll") for (int _i = 0; _i < 2; ++_i) \
        __builtin_amdgcn_global_load_lds((const unsigned*)((const char*)(gbase) + (voff)[_i]), (PG8_LAS unsigned*)(lds + (bufoff) + ldsw + _i * 8192), 16, 0, 0); } while (0)
#define PG8_LDA(dst, b, h) do { _Pragma("unroll") for (int m = 0; m < 4; ++m) _Pragma("unroll") for (int k = 0; k < 2; ++k) dst[m][k] = *(const PG8_LAS bf16x8*)(lds + PG8_SA(b, h) + aoff + m * 2048 + k * 1024); } while (0)
#define PG8_LDB(dst, b, h) do { _Pragma("unroll") for (int n = 0; n < 2; ++n) _Pragma("unroll") for (int k = 0; k < 2; ++k) dst[n][k] = *(const PG8_LAS bf16x8*)(lds + PG8_SB(b, h) + boff + n * 2048 + k * 1024); } while (0)
#define PG8_MMA(ai, bj, At, Bt) do { __builtin_amdgcn_s_setprio(1); _Pragma("unroll") for (int m = 0; m < 4; ++m) _Pragma("unroll") for (int n = 0; n < 2; ++n) _Pragma("unroll") for (int k = 0; k < 2; ++k) \
        acc[ai][bj][m][n] = __builtin_amdgcn_mfma_f32_16x16x32_bf16(Bt[n][k], At[m][k], acc[ai][bj][m][n], 0, 0, 0); __builtin_amdgcn_s_setprio(0); } while (0)
#define PG8_WAIT_V(n) asm volatile("s_waitcnt vmcnt(" #n ")" ::: "memory")
#define PG8_WAIT_L(n) asm volatile("s_waitcnt lgkmcnt(" #n ")" ::: "memory")
#define PG8_BAR __builtin_amdgcn_s_barrier()
#define PG8_SCHED __builtin_amdgcn_sched_barrier(0)
    Unit cur, nxt; int ui = 0;
    if (!S.next(0, cur)) return;
    f32x4 acc[2][2][4][2];
#pragma unroll
    for (int a = 0; a < 2; ++a)
#pragma unroll
        for (int b = 0; b < 2; ++b)
#pragma unroll
            for (int m = 0; m < 4; ++m)
#pragma unroll
                for (int n = 0; n < 2; ++n) acc[a][b][m][n] = (f32x4){0.f, 0.f, 0.f, 0.f};
    bf16x8 At[4][2], B0[2][2], B1[2][2];
    const char* cA = (const char*)g.A + (size_t)cur.pm * tstep; const char* cB = (const char*)g.Bt + (size_t)cur.pn * tstep;
    S.a_ready(cur);
    if constexpr (SP2) {
        PG8_STAGE(PG8_SB(0, 0), cB, voffB); PG8_STAGE(PG8_SB(0, 1), cB + hstep, voffB); PG8_STAGE(PG8_SA(0, 0), cA, voffA); PG8_STAGE(PG8_SA(0, 1), cA + hstep, voffA);
        if (wr == 1) PG8_BAR;
        PG8_WAIT_V(2); PG8_BAR;
        PG8_STAGE(PG8_SB(1, 0), cB + kstep, voffB); PG8_STAGE(PG8_SA(1, 0), cA + kstep, voffA); PG8_STAGE(PG8_SB(1, 1), cB + hstep + kstep, voffB);
        PG8_WAIT_V(6); PG8_BAR;
    } else {
        PG8_STAGE(PG8_SB(0, 0), cB, voffB); PG8_STAGE(PG8_SA(0, 0), cA, voffA); PG8_STAGE(PG8_SB(0, 1), cB + hstep, voffB); PG8_STAGE(PG8_SA(0, 1), cA + hstep, voffA);
        if (wr == 1) PG8_BAR;
        PG8_WAIT_V(4); PG8_BAR;
        PG8_STAGE(PG8_SB(1, 0), cB + kstep, voffB); PG8_STAGE(PG8_SA(1, 0), cA + kstep, voffA); PG8_STAGE(PG8_SB(1, 1), cB + hstep + kstep, voffB);
        PG8_WAIT_V(6); PG8_BAR;
    }
    for (;;) {
        const bool has_next = S.next(ui + 1, nxt);
        const char* nA = has_next ? (const char*)g.A + (size_t)nxt.pm * tstep : cA; const char* nB = has_next ? (const char*)g.Bt + (size_t)nxt.pn * tstep : cB;
        for (int t = 0; t < nt; t += 2) {
            const bool last = (t == nt - 2);
            const char* a1 = cA + (size_t)(t + 1) * kstep;
            const char* a2 = last ? nA : cA + (size_t)(t + 2) * kstep; const char* b2 = last ? nB : cB + (size_t)(t + 2) * kstep;
            const char* a3 = a2 + kstep; const char* b3 = b2 + kstep;
            if (last && has_next) S.a_ready(nxt);
            if constexpr (SP2) {
            PG8_LDB(B0, 0, 0); PG8_LDB(B1, 0, 1); PG8_SCHED; PG8_LDA(At, 0, 0); PG8_STAGE(PG8_SA(1, 1), a1 + hstep, voffA);
            PG8_WAIT_V(8); PG8_WAIT_L(0); PG8_BAR; PG8_MMA(0, 0, At, B0); PG8_MMA(0, 1, At, B1); PG8_BAR; PG8_SCHED;
            PG8_LDA(At, 0, 1); PG8_STAGE(PG8_SB(0, 0), b2, voffB); PG8_STAGE(PG8_SB(0, 1), b2 + hstep, voffB); PG8_STAGE(PG8_SA(0, 0), a2, voffA);
            PG8_WAIT_V(8); PG8_WAIT_L(0); PG8_BAR; PG8_MMA(1, 0, At, B0); PG8_MMA(1, 1, At, B1); PG8_BAR; PG8_SCHED;
            PG8_LDB(B0, 1, 0); PG8_LDB(B1, 1, 1); PG8_SCHED; PG8_LDA(At, 1, 0); PG8_STAGE(PG8_SA(0, 1), a2 + hstep, voffA);
            PG8_WAIT_V(8); PG8_WAIT_L(0); PG8_BAR; PG8_MMA(0, 0, At, B0); PG8_MMA(0, 1, At, B1); PG8_BAR; PG8_SCHED;
            PG8_LDA(At, 1, 1); PG8_STAGE(PG8_SB(1, 0), b3, voffB); PG8_STAGE(PG8_SB(1, 1), b3 + hstep, voffB); PG8_STAGE(PG8_SA(1, 0), a3, voffA);
            PG8_WAIT_V(8); PG8_WAIT_L(0); PG8_BAR; PG8_MMA(1, 0, At, B0); PG8_MMA(1, 1, At, B1); PG8_BAR; PG8_SCHED;
            } else {
            PG8_LDB(B0, 0, 0); PG8_SCHED; PG8_LDA(At, 0, 0); PG8_STAGE(PG8_SA(1, 1), a1 + hstep, voffA);
            PG8_WAIT_L(8); PG8_BAR; PG8_WAIT_L(0); PG8_MMA(0, 0, At, B0); PG8_BAR; PG8_SCHED;
            PG8_LDB(B1, 0, 1); PG8_STAGE(PG8_SB(0, 0), b2, voffB);
            PG8_BAR; PG8_WAIT_L(0); PG8_MMA(0, 1, At, B1); PG8_BAR;
            PG8_LDA(At, 0, 1); PG8_STAGE(PG8_SA(0, 0), a2, voffA);
            PG8_BAR; PG8_WAIT_L(0); PG8_MMA(1, 0, At, B0); PG8_BAR; PG8_SCHED;
            PG8_STAGE(PG8_SB(0, 1), b2 + hstep, voffB);
            PG8_WAIT_V(6); PG8_BAR; PG8_MMA(1, 1, At, B1); PG8_BAR;
            PG8_LDB(B0, 1, 0); PG8_SCHED; PG8_LDA(At, 1, 0); PG8_STAGE(PG8_SA(0, 1), a2 + hstep, voffA);
            PG8_WAIT_L(8); PG8_BAR; PG8_WAIT_L(0); PG8_MMA(0, 0, At, B0); PG8_BAR; PG8_SCHED;
            PG8_LDB(B1, 1, 1); PG8_STAGE(PG8_SB(1, 0), b3, voffB);
            PG8_BAR; PG8_WAIT_L(0); PG8_MMA(0, 1, At, B1); PG8_BAR;
            PG8_LDA(At, 1, 1); PG8_STAGE(PG8_SA(1, 0), a3, voffA);
            PG8_BAR; PG8_WAIT_L(0); PG8_MMA(1, 0, At, B0); PG8_BAR; PG8_SCHED;
            PG8_STAGE(PG8_SB(1, 1), b3 + hstep, voffB);
            PG8_WAIT_V(6); PG8_BAR; PG8_MMA(1, 1, At, B1); PG8_BAR;
            }
        }
        if constexpr (ALIGN_EPI) { if (wr == 0) PG8_BAR; }
        if constexpr (!Epi::AFTER_DRAIN) { E(acc, cur, wr, wc, fr, fq); S.done(cur); }
        if (!has_next) break;
#pragma unroll
        for (int a = 0; a < 2; ++a)
#pragma unroll
            for (int b = 0; b < 2; ++b)
#pragma unroll
                for (int m = 0; m < 4; ++m)
#pragma unroll
                    for (int n = 0; n < 2; ++n) acc[a][b][m][n] = (f32x4){0.f, 0.f, 0.f, 0.f};
        cur = nxt; cA = nA; cB = nB; ++ui;
        if constexpr (ALIGN_EPI) { if (wr == 1) PG8_BAR; }
    }
    PG8_WAIT_V(0);
    if constexpr (!ALIGN_EPI) { if (wr == 0) PG8_BAR; }
    PG8_BAR;
    if constexpr (Epi::AFTER_DRAIN) { E.fused(acc, cur, wr, wc, fr, fq, lds, wid, lane); S.done(cur); }
#undef PG8_SA
#undef PG8_SB
#undef PG8_STAGE
#undef PG8_LDA
#undef PG8_LDB
#undef PG8_MMA
#undef PG8_WAIT_V
#undef PG8_WAIT_L
#undef PG8_BAR
#undef PG8_SCHED
}
}

#define LAS __attribute__((address_space(3)))
typedef unsigned short bf16_t;
typedef short bf16x8 __attribute__((ext_vector_type(8)));
typedef short s16x4 __attribute__((ext_vector_type(4)));
typedef float f32x4 __attribute__((ext_vector_type(4)));
typedef float f32x2 __attribute__((ext_vector_type(2)));
typedef float f32x16 __attribute__((ext_vector_type(16)));
typedef unsigned u32x4 __attribute__((ext_vector_type(4)));
typedef unsigned u32x2 __attribute__((ext_vector_type(2)));
typedef __bf16 bf16x2_t __attribute__((ext_vector_type(2)));

constexpr int MP = 65536, MS = 512, MT = MP + MS, PAST = 2048, SKV = 2112, KVR = MP + 8 * SKV;
constexpr float EPS = 1e-6f, LOG2E = 1.4426950408889634f;
constexpr float QS_FOX = 0.125f * LOG2E, QS_MLA = 0.10206207261596575f * LOG2E, QS_MEM = 0.08838834764831845f * LOG2E;
constexpr int NTHR = 512;

constexpr size_t OFF_Y = 0;
constexpr size_t OFF_P_FOX_K = (size_t)MT * 1024;
constexpr size_t OFF_P_FOX_V = OFF_P_FOX_K + (size_t)MP * 512;
constexpr size_t OFF_P_LOGF = OFF_P_FOX_V + (size_t)MP * 512;
constexpr size_t OFF_P_CKV = OFF_P_LOGF + (size_t)MP * 8;
constexpr size_t OFF_P_KR = OFF_P_CKV + (size_t)MP * 256;
constexpr size_t OFF_P_MEM_K = OFF_P_KR + (size_t)MP * 32;
constexpr size_t OFF_P_MEM_V = OFF_P_MEM_K + (size_t)4096 * 512;
constexpr size_t OFF_S_FOX_K = OFF_P_MEM_V + (size_t)4096 * 512;
constexpr size_t OFF_S_FOX_V = OFF_S_FOX_K + (size_t)MS * 512;
constexpr size_t OFF_S_LOGF = OFF_S_FOX_V + (size_t)MS * 512;
constexpr size_t OFF_S_CKV = OFF_S_LOGF + (size_t)MS * 8;
constexpr size_t OFF_S_KR = OFF_S_CKV + (size_t)MS * 256;
constexpr size_t OUT_TOTAL = OFF_S_KR + (size_t)MS * 32;
static_assert(OUT_TOTAL == 159010816ull, "d_out map");

constexpr size_t MiB = 1u << 20;
constexpr size_t WS_W_IN = 0, WS_W_UQ = 5 * MiB, WS_W_UKV = 6 * MiB, WS_W_O = 7 * MiB, WS_W_MKV = 9 * MiB, WS_W_MQ = 11 * MiB, WS_W_MO = 12 * MiB,
                 WS_W_GU = 13 * MiB, WS_W_D = 24 * MiB, WS_ROPE = 30 * MiB, WS_SSQ = 31 * MiB, WS_CUM = 33 * MiB, WS_MEMK = 36 * MiB, WS_MEMV = 42 * MiB,
                 WS_MN = 48 * MiB, WS_XN = 56 * MiB  , WS_D = 185 * MiB;
constexpr size_t WS_ZS = WS_D, WS_QF = 282 * MiB, WS_KF = 347 * MiB, WS_VF = 428 * MiB, WS_CQR = 509 * MiB, WS_CKVB = 558 * MiB, WS_KRB = 599 * MiB,
                 WS_MQ = 605 * MiB, WS_MKN = 702 * MiB, WS_MV = 783 * MiB, WS_END = 864 * MiB;
constexpr size_t WS_CTL = 32 * MiB + 512 * 1024, CTL_BYTES = 16384;
constexpr size_t WS_XB = WS_D, WS_CQ = 314 * MiB, WS_CO = 379 * MiB, WS_H = 444 * MiB;
static_assert(WS_H + (size_t)MT * 2816 * 2 <= WS_END, "H overlay");
static_assert(WS_ZS + (size_t)MT * 384 * 4 <= WS_QF && WS_QF + (size_t)MT * 512 * 2 <= WS_KF && WS_KF + (size_t)KVR * 512 * 2 <= WS_VF && WS_VF + (size_t)KVR * 512 * 2 <= WS_CQR, "map1");
static_assert(WS_CQR + (size_t)MT * 384 * 2 <= WS_CKVB && WS_CKVB + (size_t)KVR * 256 * 2 <= WS_KRB && WS_KRB + (size_t)KVR * 32 * 2 <= WS_MQ && WS_MQ + (size_t)MT * 768 * 2 <= WS_MKN, "map2");
static_assert(WS_MKN + (size_t)KVR * 512 * 2 <= WS_MV && WS_MV + (size_t)KVR * 512 * 2 <= WS_END && WS_XN + (size_t)MT * 1024 * 2 <= WS_D, "map3");
static_assert(WS_XB + (size_t)MT * 1024 * 2 <= WS_CQ && WS_CQ + (size_t)MT * 512 * 2 <= WS_CO && WS_CO + (size_t)MT * 512 * 2 <= WS_H, "map4");

struct Params { const float* in[31]; float* out; unsigned char* ws; int ph_lo, ph_hi; };

__device__ __forceinline__ unsigned pk2(float lo, float hi) { f32x2 v = {lo, hi}; bf16x2_t b = __builtin_convertvector(v, bf16x2_t); return __builtin_bit_cast(unsigned, b); }
__device__ __forceinline__ u32x2 pk4(f32x4 v) { return (u32x2){pk2(v[0], v[1]), pk2(v[2], v[3])}; }
__device__ __forceinline__ float dot4(f32x4 v) { return (v[0] * v[0] + v[1] * v[1]) + (v[2] * v[2] + v[3] * v[3]); }
__device__ __forceinline__ float wave_sum(float v) {
#pragma unroll
    for (int o = 1; o < 64; o <<= 1) v += __shfl_xor(v, o);
    return v;
}
__device__ __forceinline__ int kvrow(int r) { return r < MP ? r : MP + ((r - MP) >> 6) * SKV + PAST + ((r - MP) & 63); }
__device__ __forceinline__ int rowpos(int r) { return r < MP ? (r & 4095) : PAST + ((r - MP) & 63); }
#define LDS_WAIT() asm volatile("s_waitcnt lgkmcnt(0)" ::: "memory")

__constant__ double ROPE_INV[16] = {1.0, 0.5623413251903491, 0.31622776601683794, 0.1778279410038923, 0.1, 0.05623413251903491, 0.031622776601683794, 0.01778279410038923,
                                    0.01, 0.005623413251903491, 0.0031622776601683794, 0.001778279410038923, 0.001, 0.0005623413251903491, 0.00031622776601683794, 0.0001778279410038923};

#define EPI_ARGS const pg8::f32x4 (&acc)[2][2][4][2], const pg8::Unit& u, int wr, int wc, int fr, int fq
#define FOR_AI_M _Pragma("unroll") for (int ai = 0; ai < 2; ++ai) _Pragma("unroll") for (int m = 0; m < 4; ++m)
#define FOR_BJ_N _Pragma("unroll") for (int bj = 0; bj < 2; ++bj) _Pragma("unroll") for (int n = 0; n < 2; ++n)

struct Epi1 {
    static constexpr bool PERM = false, AFTER_DRAIN = false;
    bf16_t *QF, *KF, *VF, *CQR; float *ZS, *SSQQ, *out;
    __device__ __forceinline__ void operator()(EPI_ARGS) const {
        const int pn = u.pn, row0 = u.pm * 256 + wr * 64 + fr, cw = wc * 32 + 4 * fq; const bool samp = u.pm >= 256;
        if (pn < 2) {
            FOR_AI_M { const int row = row0 + ai * 128 + m * 16; bf16_t* p = QF + (size_t)row * 512 + pn * 256 + cw;
                FOR_BJ_N { const f32x4 v = acc[ai][bj][m][n] * QS_FOX; *(u32x2*)(p + bj * 128 + n * 16) = pk4(v); } }
        } else if (pn < 6) {
            const bool isV = pn >= 4; bf16_t* B = isV ? VF : KF;
            float* O = out + (samp ? (isV ? OFF_S_FOX_V : OFF_S_FOX_K) : (isV ? OFF_P_FOX_V : OFF_P_FOX_K));
            const int cb = (pn & 1) * 256 + cw;
            FOR_AI_M { const int row = row0 + ai * 128 + m * 16, orow = samp ? row - MP : row, kr = kvrow(row);
                float* po = O + (size_t)orow * 512 + cb; bf16_t* pb = B + (size_t)kr * 512 + cb;
                FOR_BJ_N { const f32x4 v = acc[ai][bj][m][n]; *(f32x4*)(po + bj * 128 + n * 16) = v; *(u32x2*)(pb + bj * 128 + n * 16) = pk4(v); } }
        } else {
            FOR_AI_M { const int row = row0 + ai * 128 + m * 16; float ss = 0.f;
#pragma unroll
                for (int bj = 0; bj < 2; ++bj) { const int gc = pn * 256 + bj * 128;
                    if (gc < 1920) { bf16_t* p = CQR + (size_t)row * 384 + (gc - 1536) + cw;
#pragma unroll
                        for (int n = 0; n < 2; ++n) { const f32x4 v = acc[ai][bj][m][n]; *(u32x2*)(p + n * 16) = pk4(v); ss += dot4(v); } }
                    else { float* p = ZS + (size_t)row * 384 + (gc - 1920) + cw;
#pragma unroll
                        for (int n = 0; n < 2; ++n) *(f32x4*)(p + n * 16) = acc[ai][bj][m][n]; } }
                if (pn * 256 < 1920) { ss += __shfl_xor(ss, 16); ss += __shfl_xor(ss, 32); if (fq == 0) unsafeAtomicAdd(SSQQ + row, ss); } }
        }
    }
};
struct EpiM {
    static constexpr bool PERM = false, AFTER_DRAIN = false;
    bf16_t *MEMK, *MEMV; float* out;
    __device__ __forceinline__ void operator()(EPI_ARGS) const {
        const bool isV = u.pn >= 2; bf16_t* B = isV ? MEMV : MEMK; float* O = out + (isV ? OFF_P_MEM_V : OFF_P_MEM_K);
        const int row0 = u.pm * 256 + wr * 64 + fr, cb = (u.pn & 1) * 256 + wc * 32 + 4 * fq;
        FOR_AI_M { const int row = row0 + ai * 128 + m * 16; float* po = O + (size_t)row * 512 + cb; bf16_t* pb = B + (size_t)row * 512 + cb;
            FOR_BJ_N { const f32x4 v = acc[ai][bj][m][n]; *(f32x4*)(po + bj * 128 + n * 16) = v; *(u32x2*)(pb + bj * 128 + n * 16) = pk4(v); } }
    }
};
struct Epi3 {
    static constexpr bool PERM = false, AFTER_DRAIN = false;
    bf16_t *MKN, *MV;
    __device__ __forceinline__ void operator()(EPI_ARGS) const {
        bf16_t* B = (wc >= 2) ? MV : MKN; const int cw = (wc & 1) * 32 + 4 * fq, row0 = u.pm * 256 + wr * 64 + fr;
        FOR_AI_M { const int row = row0 + ai * 128 + m * 16;
            FOR_BJ_N { bf16_t* p = B + (size_t)row * 512 + (2 * u.pn + bj) * 64 + cw + n * 16; *(u32x2*)p = pk4(acc[ai][bj][m][n]); } }
    }
};
template <bool XB_OUT> struct EpiRes {
    static constexpr bool PERM = false, AFTER_DRAIN = false;
    const float *bp, *bs; float* Y; bf16_t* XB; float* SSQ;
    __device__ __forceinline__ void operator()(EPI_ARGS) const {
        const int row0 = u.pm * 256 + wr * 64 + fr, cb = u.pn * 256 + wc * 32 + 4 * fq;
        FOR_AI_M { const int row = row0 + ai * 128 + m * 16;
            const float* b = (u.pm >= 256) ? bs + (size_t)(row - MP) * 1024 : bp + (size_t)row * 1024; float* y = Y + (size_t)row * 1024; float ss = 0.f;
            FOR_BJ_N { const int off = cb + bj * 128 + n * 16; const f32x4 v = acc[ai][bj][m][n] + *(const f32x4*)(b + off); *(f32x4*)(y + off) = v;
                if (XB_OUT) *(u32x2*)(XB + (size_t)row * 1024 + off) = pk4(v); ss += dot4(v); }
            ss += __shfl_xor(ss, 16); ss += __shfl_xor(ss, 32); if (fq == 0) unsafeAtomicAdd(SSQ + row, ss);
            asm volatile("" ::: "memory"); }
    }
};
struct EpiScale {
    static constexpr bool PERM = false, AFTER_DRAIN = false;
    bf16_t* O; int ldo; const float* SSQ; float inv_n, qs;
    __device__ __forceinline__ void operator()(EPI_ARGS) const {
        const int row0 = u.pm * 256 + wr * 64 + fr, cb = u.pn * 256 + wc * 32 + 4 * fq;
        FOR_AI_M { const int row = row0 + ai * 128 + m * 16; const float rs = rsqrtf(SSQ[row] * inv_n + EPS) * qs; bf16_t* p = O + (size_t)row * ldo + cb;
            FOR_BJ_N { *(u32x2*)(p + bj * 128 + n * 16) = pk4(acc[ai][bj][m][n] * rs); } }
    }
};
struct EpiGLU {
    static constexpr bool PERM = false, AFTER_DRAIN = false;
    bf16_t* H; const float* SSQ;
    __device__ __forceinline__ void operator()(EPI_ARGS) const {
        const int row0 = u.pm * 256 + wr * 64 + fr, cb = u.pn * 128 + wc * 32 + 4 * fq;
        FOR_AI_M { const int row = row0 + ai * 128 + m * 16; const float rs = rsqrtf(SSQ[row] * (1.0f / 1024.0f) + EPS); bf16_t* p = H + (size_t)row * 2816 + cb;
#pragma unroll
            for (int n = 0; n < 2; ++n) { const f32x4 g = acc[ai][0][m][n] * rs, uu = acc[ai][1][m][n] * rs; f32x4 h;
#pragma unroll
                for (int e = 0; e < 4; ++e) h[e] = g[e] * uu[e] * __builtin_amdgcn_rcpf(1.0f + __builtin_amdgcn_exp2f(-g[e] * LOG2E));
                *(u32x2*)(p + n * 16) = pk4(h); } }
    }
};

struct AttnUnit {
    const bf16_t* Q; int ldq;
    const bf16_t* K; int ldk;
    const bf16_t* K2;
    const bf16_t* V; int ldv;
    const float* CK;
    const float* ROPE;
    bf16_t* O; int ldo;
    int nrows, qpos0, NT;
};
__device__ __forceinline__ int crow(int r, int hi) { return (r & 3) + 8 * (r >> 2) + 4 * hi; }
__device__ __forceinline__ s16x4 vtr(const LAS unsigned char* p) {
    typedef short v4i16_t __attribute__((ext_vector_type(4)));
    return __builtin_bit_cast(s16x4, __builtin_amdgcn_ds_read_tr16_b64_v4i16((LAS v4i16_t*)p));
}
template <int DK, int DV, int MODE>
__device__ __forceinline__ void attn_unit(const AttnUnit& d, LAS unsigned char* lds) {
    constexpr int DKM = (MODE == 1) ? 64 : DK;
    constexpr int KS = DK * 2 + 16;
    constexpr int NKC = DKM / 64, NVC = DV / 64, VSUB = DV / 32, CPRK = DKM / 8, CPRV = DV / 8;
    constexpr int KB0 = 0, KBS = 17408, VB0 = 34816, VBS = 16384, CKO = 67584;
    int tid_ = threadIdx.x; asm volatile("" : "+v"(tid_)); const int tid = tid_, lane = tid & 63, wid = __builtin_amdgcn_readfirstlane(tid >> 6), r32 = lane & 31, hi = lane >> 5;
    const bool wact = (wid * 32 < d.nrows);
    const int qpw = d.qpos0 + wid * 32;
    int tmax = (MODE == 0) ? ((qpw + 31) >> 6) : (MODE == 1) ? (qpw >> 6) : (d.NT - 1);
    if (!wact) tmax = -1;
    const int NT = d.NT;
    bf16x8 qf[DK / 16];
    {
        const bf16_t* qp = d.Q + (size_t)((wact ? wid * 32 : 0) + r32) * d.ldq + hi * 8;
#pragma unroll
        for (int ks = 0; ks < DK / 16; ++ks) qf[ks] = *(const bf16x8*)(qp + ks * 16);
    }
    if (MODE == 1) {
        const int pos = (wact ? qpw : d.qpos0) + r32; const float* cp = d.ROPE + pos * 16 + hi * 8;
        const f32x4 c0 = *(const f32x4*)cp, c1 = *(const f32x4*)(cp + 4), s0 = *(const f32x4*)(cp + 65536), s1 = *(const f32x4*)(cp + 65540);
        const u32x4 a = __builtin_bit_cast(u32x4, qf[4]), b = __builtin_bit_cast(u32x4, qf[5]); u32x4 oa, ob;
#pragma unroll
        for (int k = 0; k < 4; ++k) {
            const float x1l = __uint_as_float(a[k] << 16), x1h = __uint_as_float(a[k] & 0xffff0000u), x2l = __uint_as_float(b[k] << 16), x2h = __uint_as_float(b[k] & 0xffff0000u);
            const float cl = (k < 2) ? c0[2 * k] : c1[2 * k - 4], ch = (k < 2) ? c0[2 * k + 1] : c1[2 * k - 3], sl = (k < 2) ? s0[2 * k] : s1[2 * k - 4], sh = (k < 2) ? s0[2 * k + 1] : s1[2 * k - 3];
            oa[k] = pk2(x1l * cl - x2l * sl, x1h * ch - x2h * sh); ob[k] = pk2(x2l * cl + x1l * sl, x2h * ch + x1h * sh);
        }
        qf[4] = __builtin_bit_cast(bf16x8, oa); qf[5] = __builtin_bit_cast(bf16x8, ob);
    }
    float cq = 0.f;
    if (MODE == 0) cq = d.CK[(size_t)((wact ? qpw : d.qpos0) + r32) * 8];
    struct Stage { u32x4 k[NKC]; u32x4 v[NVC]; u32x4 k2; float ck; };
    Stage sg0, sg1; sg0.k2 = (u32x4){0u, 0u, 0u, 0u}; sg1.k2 = sg0.k2; sg0.ck = 0.f; sg1.ck = 0.f;
#define ATT_LOAD(t, SG) do { \
        _Pragma("unroll") for (int i_ = 0; i_ < NKC; ++i_) { const int id_ = tid + 512 * i_, row_ = id_ / CPRK, c_ = id_ % CPRK; \
            SG.k[i_] = *(const u32x4*)(d.K + (size_t)((t) * 64 + row_) * d.ldk + c_ * 8); } \
        _Pragma("unroll") for (int i_ = 0; i_ < NVC; ++i_) { const int id_ = tid + 512 * i_, row_ = id_ / CPRV, c_ = id_ % CPRV; \
            SG.v[i_] = *(const u32x4*)(d.V + (size_t)((t) * 64 + row_) * d.ldv + c_ * 8); } \
        if (MODE == 1) { if (tid < 256) SG.k2 = *(const u32x4*)(d.K2 + (size_t)((t) * 64 + (tid >> 2)) * 32 + (tid & 3) * 8); } \
        if (MODE == 0) { if (tid < 64) SG.ck = d.CK[(size_t)((t) * 64 + tid) * 8]; } } while (0)
#define ATT_STORE(buf, SG) do { \
        _Pragma("unroll") for (int i_ = 0; i_ < NKC; ++i_) { const int id_ = tid + 512 * i_, row_ = id_ / CPRK, c_ = id_ % CPRK; \
            *(LAS u32x4*)(lds + KB0 + (buf) * KBS + row_ * KS + c_ * 16) = SG.k[i_]; } \
        _Pragma("unroll") for (int i_ = 0; i_ < NVC; ++i_) { const int id_ = tid + 512 * i_, row_ = id_ / CPRV, c_ = id_ % CPRV; \
            *(LAS u32x4*)(lds + VB0 + (buf) * VBS + ((row_ >> 3) * VSUB + (c_ >> 2)) * 512 + (row_ & 7) * 64 + (c_ & 3) * 16) = SG.v[i_]; } \
        if (MODE == 1) { if (tid < 256) *(LAS u32x4*)(lds + KB0 + (buf) * KBS + (tid >> 2) * KS + 128 + (tid & 3) * 16) = SG.k2; } \
        if (MODE == 0) { if (tid < 64) *(LAS float*)(lds + CKO + (buf) * 256 + tid * 4) = SG.ck; } } while (0)
#define ATT_BAR() do { asm volatile("s_waitcnt lgkmcnt(0)" ::: "memory"); __builtin_amdgcn_s_barrier(); asm volatile("" ::: "memory"); } while (0)
    f32x16 o[VSUB], negm;
#pragma unroll
    for (int db = 0; db < VSUB; ++db)
#pragma unroll
        for (int i = 0; i < 16; ++i) o[db][i] = 0.f;
#pragma unroll
    for (int i = 0; i < 16; ++i) negm[i] = 0.f;
    float mst = 0.f, lrun = 0.f;
    constexpr float THR = 8.0f;
    ATT_LOAD(NT - 1, sg0); ATT_STORE(0, sg0);
    if (NT > 1) ATT_LOAD(NT - 2, sg1);
    if (NT > 2) ATT_LOAD(NT - 3, sg0);
    ATT_BAR();
    for (int j = 0; j < NT; ++j) {
        const int buf = j & 1, t = NT - 1 - j;
        if (t <= tmax) {
            const bool first = (t == tmax);
            f32x16 s[2];
            if (MODE == 0) {
                const float base = cq - mst;
#pragma unroll
                for (int sb = 0; sb < 2; ++sb)
#pragma unroll
                    for (int g = 0; g < 4; ++g) { const f32x4 ck = *(const LAS f32x4*)(lds + CKO + buf * 256 + (sb * 32 + 8 * g + 4 * hi) * 4);
#pragma unroll
                        for (int e = 0; e < 4; ++e) s[sb][4 * g + e] = base - ck[e]; }
            } else { s[0] = negm; s[1] = negm; }
            {
                const LAS unsigned char* kp = lds + KB0 + buf * KBS + r32 * KS + hi * 16;
#pragma unroll
                for (int ks = 0; ks < DK / 16; ++ks) {
                    const bf16x8 a0 = *(const LAS bf16x8*)(kp + ks * 32), a1 = *(const LAS bf16x8*)(kp + 32 * KS + ks * 32);
                    s[0] = __builtin_amdgcn_mfma_f32_32x32x16_bf16(a0, qf[ks], s[0], 0, 0, 0);
                    s[1] = __builtin_amdgcn_mfma_f32_32x32x16_bf16(a1, qf[ks], s[1], 0, 0, 0);
                }
            }
            if (MODE == 0) {
                if (t * 64 + 63 > qpw) {
                    const int qp = qpw + r32;
#pragma unroll
                    for (int sb = 0; sb < 2; ++sb)
#pragma unroll
                        for (int i = 0; i < 16; ++i) { const int kvp = t * 64 + sb * 32 + crow(i, hi); if (kvp > qp) s[sb][i] = -1e30f; }
                }
            }
            float rm = fmaxf(fmaxf(s[0][0], s[0][1]), s[0][2]);
#pragma unroll
            for (int i = 3; i < 15; i += 2) rm = fmaxf(fmaxf(rm, s[0][i]), s[0][i + 1]);
            rm = fmaxf(fmaxf(rm, s[0][15]), s[1][0]);
#pragma unroll
            for (int i = 1; i < 15; i += 2) rm = fmaxf(fmaxf(rm, s[1][i]), s[1][i + 1]);
            rm = fmaxf(rm, s[1][15]);
            { auto rr = __builtin_amdgcn_permlane32_swap(__float_as_uint(rm), __float_as_uint(rm), false, false); rm = fmaxf(__uint_as_float(rr[0]), __uint_as_float(rr[1])); }
            if (first || __any(rm > THR)) {
                const float dl = first ? rm : fmaxf(rm, 0.f);
                mst += dl;
#pragma unroll
                for (int sb = 0; sb < 2; ++sb)
#pragma unroll
                    for (int i = 0; i < 16; ++i) s[sb][i] -= dl;
                if (!first) { const float f = __builtin_amdgcn_exp2f(-dl); lrun *= f;
#pragma unroll
                    for (int db = 0; db < VSUB; ++db) o[db] *= f; }
#pragma unroll
                for (int i = 0; i < 16; ++i) negm[i] = -mst;
            }
#pragma unroll
            for (int sb = 0; sb < 2; ++sb)
#pragma unroll
                for (int i = 0; i < 16; ++i) s[sb][i] = __builtin_amdgcn_exp2f(s[sb][i]);
            {
                f32x2 a2 = (f32x2){s[0][0], s[0][1]} + (f32x2){s[1][0], s[1][1]};
#pragma unroll
                for (int i = 2; i < 16; i += 2) { a2 += (f32x2){s[0][i], s[0][i + 1]}; a2 += (f32x2){s[1][i], s[1][i + 1]}; }
                lrun += a2[0] + a2[1];
            }
            bf16x8 pf[4];
#pragma unroll
            for (int st = 0; st < 4; ++st) { const int sb = st >> 1, b8 = (st & 1) * 8;
                u32x4 w; w[0] = pk2(s[sb][b8 + 0], s[sb][b8 + 1]); w[1] = pk2(s[sb][b8 + 2], s[sb][b8 + 3]); w[2] = pk2(s[sb][b8 + 4], s[sb][b8 + 5]); w[3] = pk2(s[sb][b8 + 6], s[sb][b8 + 7]);
                pf[st] = __builtin_bit_cast(bf16x8, w); }
            const LAS unsigned char* vp = lds + VB0 + buf * VBS + (4 * hi + ((lane & 15) >> 2)) * 64 + ((lane >> 4) & 1) * 32 + (lane & 3) * 8;
#pragma unroll
            for (int st = 0; st < 4; ++st)
#pragma unroll
                for (int db = 0; db < VSUB; ++db) {
                    const s16x4 lo = vtr(vp + ((2 * st) * VSUB + db) * 512), hh = vtr(vp + ((2 * st + 1) * VSUB + db) * 512);
                    const bf16x8 vf = __builtin_shufflevector(lo, hh, 0, 1, 2, 3, 4, 5, 6, 7);
                    o[db] = __builtin_amdgcn_mfma_f32_32x32x16_bf16(vf, pf[st], o[db], 0, 0, 0);
                }
        }
        if (buf == 0) { if (j + 1 < NT) ATT_STORE(1, sg1); if (j + 3 < NT) ATT_LOAD(NT - 4 - j, sg1); }
        else          { if (j + 1 < NT) ATT_STORE(0, sg0); if (j + 3 < NT) ATT_LOAD(NT - 4 - j, sg0); }
        ATT_BAR();
    }
    if (wact) {
        const float lt = lrun + __shfl_xor(lrun, 32), inv = 1.0f / lt;
        bf16_t* op = d.O + (size_t)(wid * 32 + r32) * d.ldo + 4 * hi;
#pragma unroll
        for (int db = 0; db < VSUB; ++db)
#pragma unroll
            for (int g = 0; g < 4; ++g) { const f32x4 v = (f32x4){o[db][4 * g], o[db][4 * g + 1], o[db][4 * g + 2], o[db][4 * g + 3]} * inv; *(u32x2*)(op + db * 32 + 8 * g) = pk4(v); }
    }
#undef ATT_LOAD
#undef ATT_STORE
#undef ATT_BAR
}

template <int DK, int DV, int MODE, int ORD>
__device__ __forceinline__ void attn_unit_pipe(const AttnUnit& d, LAS unsigned char* lds) {
    static_assert(MODE == 0 || MODE == 1, "pipelined attention: FoX or MLA");
    constexpr int KS = DK * 2 + 16;
    constexpr int VSUB = DV / 32;
    constexpr int KB0 = 0, KBS = 17408, VB0 = 34816, VBS = 16384, CKO = 67584;
    int tid_ = threadIdx.x; asm volatile("" : "+v"(tid_)); const int tid = tid_, lane = tid & 63, wid = __builtin_amdgcn_readfirstlane(tid >> 6), r32 = lane & 31, hi = lane >> 5;
    const bool wact = (wid * 32 < d.nrows);
    const int qpw = d.qpos0 + wid * 32;
    int tmax = (MODE == 0) ? ((qpw + 31) >> 6) : (qpw >> 6);
    if (!wact) tmax = -1;
    const int NT = d.NT, j0 = NT - 1 - tmax;
    bf16x8 qf[DK / 16];
    {
        const bf16_t* qp = d.Q + (size_t)((wact ? wid * 32 : 0) + r32) * d.ldq + hi * 8;
#pragma unroll
        for (int ks = 0; ks < DK / 16; ++ks) qf[ks] = *(const bf16x8*)(qp + ks * 16);
    }
    if (MODE == 1) {
        const int pos = (wact ? qpw : d.qpos0) + r32; const float* cp = d.ROPE + pos * 16 + hi * 8;
        const f32x4 c0 = *(const f32x4*)cp, c1 = *(const f32x4*)(cp + 4), s0 = *(const f32x4*)(cp + 65536), s1 = *(const f32x4*)(cp + 65540);
        const u32x4 a = __builtin_bit_cast(u32x4, qf[4]), b = __builtin_bit_cast(u32x4, qf[5]); u32x4 oa, ob;
#pragma unroll
        for (int k = 0; k < 4; ++k) {
            const float x1l = __uint_as_float(a[k] << 16), x1h = __uint_as_float(a[k] & 0xffff0000u), x2l = __uint_as_float(b[k] << 16), x2h = __uint_as_float(b[k] & 0xffff0000u);
            const float cl = (k < 2) ? c0[2 * k] : c1[2 * k - 4], ch = (k < 2) ? c0[2 * k + 1] : c1[2 * k - 3], sl = (k < 2) ? s0[2 * k] : s1[2 * k - 4], sh = (k < 2) ? s0[2 * k + 1] : s1[2 * k - 3];
            oa[k] = pk2(x1l * cl - x2l * sl, x1h * ch - x2h * sh); ob[k] = pk2(x2l * cl + x1l * sl, x2h * ch + x1h * sh);
        }
        qf[4] = __builtin_bit_cast(bf16x8, oa); qf[5] = __builtin_bit_cast(bf16x8, ob);
    }
    float cq = 0.f;
    if (MODE == 0) cq = d.CK[(size_t)((wact ? qpw : d.qpos0) + r32) * 8];
    struct StK { u32x4 k; u32x4 k2; float ck; };
    StK ka, kb; ka.k2 = (u32x4){0u, 0u, 0u, 0u}; kb.k2 = ka.k2; ka.ck = 0.f; kb.ck = 0.f;
    u32x4 va, vb;
    const int srow = tid >> 3, sc8 = tid & 7;
#define PL_LOADK(j, SG) do { const int t_ = NT - 1 - (j); \
        SG.k = *(const u32x4*)(d.K + (size_t)(t_ * 64 + srow) * d.ldk + sc8 * 8); \
        if (MODE == 1) { if (tid < 256) SG.k2 = *(const u32x4*)(d.K2 + (size_t)(t_ * 64 + (tid >> 2)) * 32 + (tid & 3) * 8); } \
        if (MODE == 0) { if (tid < 64) SG.ck = d.CK[(size_t)(t_ * 64 + tid) * 8]; } } while (0)
#define PL_LOADV(j, VR) do { const int t_ = NT - 1 - (j); VR = *(const u32x4*)(d.V + (size_t)(t_ * 64 + srow) * d.ldv + sc8 * 8); } while (0)
#define PL_STOREK(buf, SG) do { \
        *(LAS u32x4*)(lds + KB0 + (buf) * KBS + srow * KS + sc8 * 16) = SG.k; \
        if (MODE == 1) { if (tid < 256) *(LAS u32x4*)(lds + KB0 + (buf) * KBS + (tid >> 2) * KS + 128 + (tid & 3) * 16) = SG.k2; } \
        if (MODE == 0) { if (tid < 64) *(LAS float*)(lds + CKO + (buf) * 256 + tid * 4) = SG.ck; } } while (0)
#define PL_STOREV(buf, VR) do { *(LAS u32x4*)(lds + VB0 + (buf) * VBS + ((srow >> 3) * VSUB + (sc8 >> 2)) * 512 + (srow & 7) * 64 + (sc8 & 3) * 16) = VR; } while (0)
#define PL_BAR() do { asm volatile("s_waitcnt lgkmcnt(0)" ::: "memory"); __builtin_amdgcn_s_barrier(); asm volatile("" ::: "memory"); } while (0)
    f32x16 o[VSUB], negm;
#pragma unroll
    for (int db = 0; db < VSUB; ++db)
#pragma unroll
        for (int i = 0; i < 16; ++i) o[db][i] = 0.f;
#pragma unroll
    for (int i = 0; i < 16; ++i) negm[i] = 0.f;
    float mst = 0.f, lrun = 0.f;
    constexpr float THR = 8.0f;
#define PL_QK(S, kb_) do { \
        if (MODE == 0) { const float base_ = cq - mst; \
            _Pragma("unroll") for (int sb = 0; sb < 2; ++sb) _Pragma("unroll") for (int g = 0; g < 4; ++g) { \
                const f32x4 ck_ = *(const LAS f32x4*)(lds + CKO + (kb_) * 256 + (sb * 32 + 8 * g + 4 * hi) * 4); \
                _Pragma("unroll") for (int e = 0; e < 4; ++e) S[sb][4 * g + e] = base_ - ck_[e]; } } \
        else { S[0] = negm; S[1] = negm; } \
        const LAS unsigned char* kp_ = lds + KB0 + (kb_) * KBS + r32 * KS + hi * 16; \
        _Pragma("unroll") for (int ks = 0; ks < DK / 16; ++ks) { \
            const bf16x8 a0_ = *(const LAS bf16x8*)(kp_ + ks * 32), a1_ = *(const LAS bf16x8*)(kp_ + 32 * KS + ks * 32); \
            S[0] = __builtin_amdgcn_mfma_f32_32x32x16_bf16(a0_, qf[ks], S[0], 0, 0, 0); \
            S[1] = __builtin_amdgcn_mfma_f32_32x32x16_bf16(a1_, qf[ks], S[1], 0, 0, 0); } } while (0)
#define PL_SOFT_PV(j, PAR, SC, SN, FIXN) do { \
            const bool first_ = ((j) == j0); const int t_ = NT - 1 - (j); \
            if (MODE == 0) { if (t_ * 64 + 63 > qpw) { const int qp_ = qpw + r32; \
                _Pragma("unroll") for (int sb = 0; sb < 2; ++sb) _Pragma("unroll") for (int i = 0; i < 16; ++i) { const int kvp_ = t_ * 64 + sb * 32 + crow(i, hi); if (kvp_ > qp_) SC[sb][i] = -1e30f; } } } \
            float rm_ = fmaxf(fmaxf(SC[0][0], SC[0][1]), SC[0][2]); \
            _Pragma("unroll") for (int i = 3; i < 15; i += 2) rm_ = fmaxf(fmaxf(rm_, SC[0][i]), SC[0][i + 1]); \
            rm_ = fmaxf(fmaxf(rm_, SC[0][15]), SC[1][0]); \
            _Pragma("unroll") for (int i = 1; i < 15; i += 2) rm_ = fmaxf(fmaxf(rm_, SC[1][i]), SC[1][i + 1]); \
            rm_ = fmaxf(rm_, SC[1][15]); \
            { auto rr_ = __builtin_amdgcn_permlane32_swap(__float_as_uint(rm_), __float_as_uint(rm_), false, false); rm_ = fmaxf(__uint_as_float(rr_[0]), __uint_as_float(rr_[1])); } \
            if (first_ || __any(rm_ > THR)) { \
                const float dl_ = first_ ? rm_ : fmaxf(rm_, 0.f); mst += dl_; \
                _Pragma("unroll") for (int sb = 0; sb < 2; ++sb) _Pragma("unroll") for (int i = 0; i < 16; ++i) SC[sb][i] -= dl_; \
                if (FIXN) { _Pragma("unroll") for (int sb = 0; sb < 2; ++sb) _Pragma("unroll") for (int i = 0; i < 16; ++i) SN[sb][i] -= dl_; } \
                if (!first_) { const float f_ = __builtin_amdgcn_exp2f(-dl_); lrun *= f_; _Pragma("unroll") for (int db = 0; db < VSUB; ++db) o[db] *= f_; } \
                _Pragma("unroll") for (int i = 0; i < 16; ++i) negm[i] = -mst; } \
            _Pragma("unroll") for (int sb = 0; sb < 2; ++sb) _Pragma("unroll") for (int i = 0; i < 16; ++i) SC[sb][i] = __builtin_amdgcn_exp2f(SC[sb][i]); \
            { float a0_ = SC[0][0] + SC[1][0], a1_ = SC[0][1] + SC[1][1]; \
              _Pragma("unroll") for (int i = 2; i < 16; i += 2) { a0_ += SC[0][i]; a1_ += SC[0][i + 1]; a0_ += SC[1][i]; a1_ += SC[1][i + 1]; } \
              lrun += a0_ + a1_; } \
            bf16x8 pf_[4]; \
            _Pragma("unroll") for (int st = 0; st < 4; ++st) { const int sb = st >> 1, b8 = (st & 1) * 8; u32x4 w_; \
                w_[0] = pk2(SC[sb][b8 + 0], SC[sb][b8 + 1]); w_[1] = pk2(SC[sb][b8 + 2], SC[sb][b8 + 3]); w_[2] = pk2(SC[sb][b8 + 4], SC[sb][b8 + 5]); w_[3] = pk2(SC[sb][b8 + 6], SC[sb][b8 + 7]); \
                pf_[st] = __builtin_bit_cast(bf16x8, w_); } \
            const LAS unsigned char* vp_ = lds + VB0 + (PAR) * VBS + (4 * hi + ((lane & 15) >> 2)) * 64 + ((lane >> 4) & 1) * 32 + (lane & 3) * 8; \
            _Pragma("unroll") for (int st = 0; st < 4; ++st) _Pragma("unroll") for (int db = 0; db < VSUB; ++db) { \
                const s16x4 lo_ = vtr(vp_ + ((2 * st) * VSUB + db) * 512), hh_ = vtr(vp_ + ((2 * st + 1) * VSUB + db) * 512); \
                const bf16x8 vf_ = __builtin_shufflevector(lo_, hh_, 0, 1, 2, 3, 4, 5, 6, 7); \
                o[db] = __builtin_amdgcn_mfma_f32_32x32x16_bf16(vf_, pf_[st], o[db], 0, 0, 0); } } while (0)
#define PL_STEP(j, PAR, SC, SN, KSG, VR) do { \
        const bool has_nxt_ = ((j) + 1 < NT) && ((j) + 1 >= j0); \
        if (ORD == 0) { \
            if (has_nxt_) PL_QK(SN, (PAR) ^ 1); \
            if ((j) >= j0) PL_SOFT_PV(j, PAR, SC, SN, has_nxt_); \
        } else { \
            if ((j) >= j0) PL_SOFT_PV(j, PAR, SC, SN, false); \
            if (has_nxt_) PL_QK(SN, (PAR) ^ 1); \
        } \
        if ((j) + 2 < NT) PL_STOREK(PAR, KSG); \
        if ((j) + 1 < NT) PL_STOREV((PAR) ^ 1, VR); \
        if ((j) + 4 < NT) PL_LOADK((j) + 4, KSG); \
        if ((j) + 3 < NT) PL_LOADV((j) + 3, VR); \
        PL_BAR(); } while (0)
    PL_LOADK(0, ka); PL_LOADV(0, va); if (NT > 1) PL_LOADK(1, kb);
    PL_STOREK(0, ka); PL_STOREV(0, va); if (NT > 1) PL_STOREK(1, kb);
    if (NT > 2) PL_LOADK(2, ka); if (NT > 3) PL_LOADK(3, kb); if (NT > 1) PL_LOADV(1, vb); if (NT > 2) PL_LOADV(2, va);
    PL_BAR();
    f32x16 sa[2], sb2[2];
#pragma unroll
    for (int i = 0; i < 16; ++i) { sa[0][i] = 0.f; sa[1][i] = 0.f; sb2[0][i] = 0.f; sb2[1][i] = 0.f; }
    if (0 >= j0) PL_QK(sa, 0);
    PL_BAR();
    for (int j = 0; j < NT; j += 2) {
        PL_STEP(j, 0, sa, sb2, ka, vb);
        if (j + 1 < NT) PL_STEP(j + 1, 1, sb2, sa, kb, va);
    }
    if (wact) {
        const float lt = lrun + __shfl_xor(lrun, 32), inv = 1.0f / lt;
        bf16_t* op = d.O + (size_t)(wid * 32 + r32) * d.ldo + 4 * hi;
#pragma unroll
        for (int db = 0; db < VSUB; ++db)
#pragma unroll
            for (int g = 0; g < 4; ++g) { const f32x4 v = (f32x4){o[db][4 * g], o[db][4 * g + 1], o[db][4 * g + 2], o[db][4 * g + 3]} * inv; *(u32x2*)(op + db * 32 + 8 * g) = pk4(v); }
    }
#undef PL_LOADK
#undef PL_LOADV
#undef PL_STOREK
#undef PL_STOREV
#undef PL_BAR
#undef PL_QK
#undef PL_SOFT_PV
#undef PL_STEP
}

__device__ __forceinline__ void transpose_item(const float* __restrict__ W, int ldw, int srccol0, int nvalid, const float* __restrict__ gk,
                                               bf16_t* WT, int K, int dstrow0, int k0, LAS float* scr, int lane) {
#pragma unroll
    for (int i = 0; i < 32; ++i) { const int kk = 2 * i + (lane >> 5), n = lane & 31; float v = 0.f;
        if (n < nvalid) { v = W[(size_t)(k0 + kk) * ldw + srccol0 + n]; if (gk) v *= gk[k0 + kk]; }
        scr[kk * 33 + n] = v; }
    LDS_WAIT();
    const int c = lane & 7;
#pragma unroll
    for (int j = 0; j < 4; ++j) { const int n = (lane >> 3) + 8 * j; const LAS float* s = scr + (8 * c) * 33 + n;
        u32x4 o; o.x = pk2(s[0 * 33], s[1 * 33]); o.y = pk2(s[2 * 33], s[3 * 33]); o.z = pk2(s[4 * 33], s[5 * 33]); o.w = pk2(s[6 * 33], s[7 * 33]);
        *(u32x4*)(WT + (size_t)(dstrow0 + n) * K + k0 + 8 * c) = o; }
    LDS_WAIT();
}
__device__ __forceinline__ void rms_rows4_to_bf16(const float* xrow, const float* g, bf16_t* orow, int lane) {
    f32x4 v[16]; float s[4];
#pragma unroll
    for (int j = 0; j < 16; ++j) v[j] = ((const f32x4*)xrow)[lane + 64 * j];
#pragma unroll
    for (int k = 0; k < 4; ++k) { s[k] = (dot4(v[4 * k]) + dot4(v[4 * k + 1])) + (dot4(v[4 * k + 2]) + dot4(v[4 * k + 3])); }
#pragma unroll
    for (int k = 0; k < 4; ++k) s[k] = rsqrtf(wave_sum(s[k]) * (1.0f / 1024.0f) + EPS);
#pragma unroll
    for (int j = 0; j < 16; ++j) { const f32x4 gg = ((const f32x4*)g)[lane + 64 * (j & 3)]; ((u32x2*)orow)[lane + 64 * j] = pk4(v[j] * s[j >> 2] * gg); }
}
template <int W8, int RPG>
__device__ __forceinline__ void cvt_rows(const float* src, bf16_t* dst, int nrows, int drow0, int dstride, unsigned gtid, unsigned gthreads) {
    const unsigned total = (unsigned)nrows * W8;
    for (unsigned idx = gtid; idx < total; idx += 2 * gthreads) {
        const unsigned idx2 = idx + gthreads; const bool two = idx2 < total;
        const f32x4 a = *(const f32x4*)(src + (size_t)idx * 8), b = *(const f32x4*)(src + (size_t)idx * 8 + 4);
        f32x4 c = a, e = b; if (two) { c = *(const f32x4*)(src + (size_t)idx2 * 8); e = *(const f32x4*)(src + (size_t)idx2 * 8 + 4); }
        { const unsigned row = idx / W8, c8 = idx % W8, drow = drow0 + (row / RPG) * dstride + (row % RPG);
          *(u32x4*)(dst + ((size_t)drow * W8 + c8) * 8) = (u32x4){pk2(a[0], a[1]), pk2(a[2], a[3]), pk2(b[0], b[1]), pk2(b[2], b[3])}; }
        if (two) { const unsigned row = idx2 / W8, c8 = idx2 % W8, drow = drow0 + (row / RPG) * dstride + (row % RPG);
          *(u32x4*)(dst + ((size_t)drow * W8 + c8) * 8) = (u32x4){pk2(c[0], c[1]), pk2(c[2], c[3]), pk2(e[0], e[1]), pk2(e[2], e[3])}; }
    }
}

#define XB_TMO      128
#define XB_XCNT(j)  (256  + 64 * (j))
#define XB_XSUB(j)  (1280 + 64 * (j))
#define XB_XGEN(j)  (2304 + 64 * (j))
#define XB_TOP      3328
#define XB_TOPGEN   3392
#define XCD_BAR_WORDS 3456
#define XB_SPIN_CAP (1u << 18)

__device__ __forceinline__ unsigned xb_ld(unsigned* p)              { return __hip_atomic_load(p, __ATOMIC_RELAXED, __HIP_MEMORY_SCOPE_AGENT); }
__device__ __forceinline__ unsigned xb_add(unsigned* p, unsigned v) { return __hip_atomic_fetch_add(p, v, __ATOMIC_RELAXED, __HIP_MEMORY_SCOPE_AGENT); }
__device__ __forceinline__ unsigned xb_xcc_id() { return (unsigned)__builtin_amdgcn_s_getreg((3 << 11) | 20) & 0xFu; }
#define XB_SPIN(cond, bar) do { unsigned _sp = 0; while (cond) { __builtin_amdgcn_s_sleep(1); \
    if ((++_sp & 255u) == 0u) { if (xb_ld(&(bar)[XB_TMO])) break; if (_sp > XB_SPIN_CAP) { atomicAdd(&(bar)[XB_TMO], 1u); break; } } } } while (0)

struct XcdBarrier {
    unsigned* bar; unsigned x;
    volatile LAS unsigned* st;
};

__device__ __forceinline__ XcdBarrier xcd_barrier_post(unsigned* bar, volatile LAS unsigned* st) {
    XcdBarrier b; b.bar = bar; b.x = xb_xcc_id(); b.st = st;
    if (threadIdx.x == 0) (void)xb_add(&bar[XB_XCNT(b.x)], 1u);
    return b;
}
__device__ __forceinline__ void xcd_barrier_complete(unsigned* bar, unsigned x, unsigned& nloc, unsigned& nx) {
    const unsigned G = gridDim.x * gridDim.y * gridDim.z;
    unsigned sum, cnt, mine, sp = 0u;
    for (;;) {
        sum = 0u; cnt = 0u; mine = 0u;
#pragma unroll
        for (unsigned j = 0; j < 16; ++j) { const unsigned c = xb_ld(&bar[XB_XCNT(j)]); sum += c; cnt += (c > 0u) ? 1u : 0u; mine = (j == x) ? c : mine; }
        if (sum == G) break;
        __builtin_amdgcn_s_sleep(1);
        if ((++sp & 255u) == 0u) { if (xb_ld(&bar[XB_TMO])) break; if (sp > XB_SPIN_CAP) { atomicAdd(&bar[XB_TMO], 1u); break; } }
    }
    nloc = mine > 0u ? mine : 1u; nx = cnt > 0u ? cnt : 1u;
}

__device__ __forceinline__ void xcd_barrier(const XcdBarrier& b) {
    asm volatile("s_waitcnt vmcnt(0)" ::: "memory");
    __syncthreads();
    if (threadIdx.x == 0) {
        unsigned* bar = b.bar;
        __builtin_amdgcn_s_waitcnt(0);
        unsigned nloc = b.st[0], nx = b.st[1];
        if (nloc == 0u) { xcd_barrier_complete(bar, b.x, nloc, nx); b.st[0] = nloc; b.st[1] = nx; }
        const unsigned old = xb_add(&bar[XB_XSUB(b.x)], 1u);
        const unsigned gen = old / nloc;
        if (old + 1u == (gen + 1u) * nloc) {
            __builtin_amdgcn_fence(__ATOMIC_RELEASE, "agent");
            asm volatile("s_waitcnt vmcnt(0)" ::: "memory");
            const unsigned og = xb_add(&bar[XB_TOP], 1u);
            const unsigned tg = og / nx;
            if (og + 1u == (tg + 1u) * nx) xb_add(&bar[XB_TOPGEN], 1u);
            else XB_SPIN(xb_ld(&bar[XB_TOPGEN]) == tg, bar);
            __builtin_amdgcn_fence(__ATOMIC_ACQUIRE, "agent");
            xb_add(&bar[XB_XGEN(b.x)], 1u);
            asm volatile("s_waitcnt vmcnt(0)" ::: "memory");
        } else {
            XB_SPIN(xb_ld(&bar[XB_XGEN(b.x)]) == gen, bar);
            __builtin_amdgcn_fence(__ATOMIC_ACQUIRE, "agent");
            asm volatile("s_waitcnt vmcnt(0)" ::: "memory");
        }
    }
    __syncthreads();
}

constexpr int LDS_BYTES = 135168;
__global__ void __launch_bounds__(NTHR, 2) fwd_kernel(Params P) {
    extern __shared__ __attribute__((aligned(16))) unsigned char lds_raw[];
    LAS unsigned char* lds = (LAS unsigned char*)lds_raw;
    cg::grid_group grid = cg::this_grid();
    if (threadIdx.x < 64) ((LAS unsigned*)(lds + 131072))[threadIdx.x] = 0u;
    __syncthreads();
    XcdBarrier xbar = xcd_barrier_post((unsigned*)(P.ws + WS_CTL), (volatile LAS unsigned*)(lds + 131072) + 8);
    const int wid = __builtin_amdgcn_readfirstlane(threadIdx.x >> 6);
    const int G = gridDim.x, bx = blockIdx.x;
#define FRESH_TID() int tid_ = threadIdx.x; asm volatile("" : "+v"(tid_)); const int tid = tid_, lane = tid & 63; (void)lane; const size_t gtid = (size_t)bx * NTHR + tid; (void)gtid
    const int vcu = (G % 8 == 0) ? (bx % 8) * (G / 8) + bx / 8 : bx;
    const int gw = bx * 8 + wid, NGW = G * 8;
    const size_t gthreads = (size_t)G * NTHR;
    unsigned char* ws = P.ws; float* out = P.out;
    bf16_t *W_IN = (bf16_t*)(ws + WS_W_IN), *W_UQ = (bf16_t*)(ws + WS_W_UQ), *W_UKV = (bf16_t*)(ws + WS_W_UKV), *W_O = (bf16_t*)(ws + WS_W_O), *W_MKV = (bf16_t*)(ws + WS_W_MKV),
           *W_MQ = (bf16_t*)(ws + WS_W_MQ), *W_MO = (bf16_t*)(ws + WS_W_MO), *W_GU = (bf16_t*)(ws + WS_W_GU), *W_D = (bf16_t*)(ws + WS_W_D);
    float *COS = (float*)(ws + WS_ROPE), *SIN = COS + 4096 * 16;
    float *SSQQ = (float*)(ws + WS_SSQ), *SSQ1 = SSQQ + MT, *SSQ2 = SSQ1 + MT, *SSQ3 = SSQ2 + MT;
    float* CUM = (float*)(ws + WS_CUM);
    bf16_t *MEMK = (bf16_t*)(ws + WS_MEMK), *MEMV = (bf16_t*)(ws + WS_MEMV), *MN = (bf16_t*)(ws + WS_MN), *XN = (bf16_t*)(ws + WS_XN), *ATT = XN;
    float* ZS = (float*)(ws + WS_ZS);
    bf16_t *QF = (bf16_t*)(ws + WS_QF), *KF = (bf16_t*)(ws + WS_KF), *VF = (bf16_t*)(ws + WS_VF), *CQR = (bf16_t*)(ws + WS_CQR), *CKVB = (bf16_t*)(ws + WS_CKVB), *KRB = (bf16_t*)(ws + WS_KRB),
           *MQ = (bf16_t*)(ws + WS_MQ), *MKN = (bf16_t*)(ws + WS_MKN), *MV = (bf16_t*)(ws + WS_MV);
    bf16_t *XB = (bf16_t*)(ws + WS_XB), *CQ = (bf16_t*)(ws + WS_CQ), *CO = (bf16_t*)(ws + WS_CO), *HB = (bf16_t*)(ws + WS_H);
    const int lo = P.ph_lo, hi_ph = P.ph_hi;
#ifndef PHASE_MASK
#define PHASE_MASK 0x1fff
#endif
#define IN(k) (((PHASE_MASK >> (k)) & 1) && lo <= (k) && (k) < hi_ph)
#define SEAM(k) do { if (IN(k) && IN((k) + 1)) { if (P.ph_lo < 0) grid.sync(); else xcd_barrier(xbar); } } while (0)

    if (IN(0)) {
        FRESH_TID();
        for (size_t i = gtid; i < (size_t)4 * MT; i += gthreads) SSQQ[i] = 0.f;
        for (size_t i = gtid; i < (size_t)4096 * 16; i += gthreads) {
            const int pos = (int)(i >> 4), j = (int)(i & 15); const double a = (double)pos * ROPE_INV[j] * 0.15915494309189535; const float fr_ = (float)(a - floor(a));
            COS[i] = __builtin_amdgcn_cosf(fr_); SIN[i] = __builtin_amdgcn_sinf(fr_);
        }
        {
            LAS float* scr = (LAS float*)(lds + wid * 16384);
            constexpr int I1 = 16 * 72, I2 = 6 * 24, I3 = 4 * 32, I4 = 16 * 32, I5 = 16 * 32, I6 = 16 * 16, I7 = 8 * 32, I8 = 16 * 176, I9 = 44 * 32;
            constexpr int NIT = I1 + I2 + I3 + I4 + I5 + I6 + I7 + I8 + I9;
            for (int it = gw; it < NIT; it += NGW) {
                int r = it;
                if (r < I1) { const int kb = r / 72, nb = r % 72, n0 = nb * 32; int src, nv;
                    if (n0 < 1536) { src = n0; nv = 32; } else if (n0 < 2208) { src = n0 + 8; nv = 32; } else if (n0 == 2208) { src = 1536; nv = 8; } else { src = 0; nv = 0; }
                    transpose_item(P.in[11], 2216, src, nv, nullptr, W_IN, 1024, n0, kb * 64, scr, lane); continue; } r -= I1;
                if (r < I2) { const int kb = r / 24, nb = r % 24; transpose_item(P.in[14], 768, nb * 32, 32, P.in[13], W_UQ, 384, nb * 32, kb * 64, scr, lane); continue; } r -= I2;
                if (r < I3) { const int kb = r / 32, nb = r % 32; transpose_item(P.in[16], 1024, nb * 32, 32, nullptr, W_UKV, 256, nb * 32, kb * 64, scr, lane); continue; } r -= I3;
                if (r < I4) { const int kb = r / 32, nb = r % 32; transpose_item(P.in[19], 1024, nb * 32, 32, nullptr, W_O, 1024, nb * 32, kb * 64, scr, lane); continue; } r -= I4;
                if (r < I5) { const int kb = r / 32, nb = r % 32; transpose_item(nb < 16 ? P.in[21] : P.in[22], 512, (nb & 15) * 32, 32, nullptr, W_MKV, 1024, nb * 32, kb * 64, scr, lane); continue; } r -= I5;
                if (r < I6) { const int kb = r / 16, nb = r % 16; transpose_item(P.in[24], 512, nb * 32, 32, P.in[23], W_MQ, 1024, nb * 32, kb * 64, scr, lane); continue; } r -= I6;
                if (r < I7) { const int kb = r / 32, nb = r % 32; transpose_item(P.in[25], 1024, nb * 32, 32, nullptr, W_MO, 512, nb * 32, kb * 64, scr, lane); continue; } r -= I7;
                if (r < I8) { const int kb = r / 176, nb = r % 176, tile = nb >> 3, j = nb & 7;
                    transpose_item(j < 4 ? P.in[27] : P.in[28], 2816, tile * 128 + (j & 3) * 32, 32, P.in[26], W_GU, 1024, nb * 32, kb * 64, scr, lane); continue; } r -= I8;
                { const int kb = r / 32, nb = r % 32; transpose_item(P.in[29], 1024, nb * 32, 32, nullptr, W_D, 2816, nb * 32, kb * 64, scr, lane); }
            }
        }
        for (int m = gw * 4; m < MT; m += NGW * 4) rms_rows4_to_bf16(m < MP ? P.in[0] + (size_t)m * 1024 : P.in[1] + (size_t)(m - MP) * 1024, P.in[10], XN + (size_t)m * 1024, lane);
        for (int m = gw * 4; m < 4096; m += NGW * 4) rms_rows4_to_bf16(P.in[2] + (size_t)m * 1024, P.in[20], MN + (size_t)m * 1024, lane);
        cvt_rows<64, 2048>(P.in[3], KF, 16384, MP, SKV, (unsigned)gtid, (unsigned)gthreads);
        cvt_rows<64, 2048>(P.in[4], VF, 16384, MP, SKV, (unsigned)gtid, (unsigned)gthreads);
        cvt_rows<32, 2048>(P.in[6], CKVB, 16384, MP, SKV, (unsigned)gtid, (unsigned)gthreads);
        cvt_rows<4, 2048>(P.in[7], KRB, 16384, MP, SKV, (unsigned)gtid, (unsigned)gthreads);
        cvt_rows<64, 2048>(P.in[8], MEMK, 2048, 4096, 0, (unsigned)gtid, (unsigned)gthreads);
        cvt_rows<64, 2048>(P.in[9], MEMV, 2048, 4096, 0, (unsigned)gtid, (unsigned)gthreads);
    }
    SEAM(0);
    if (IN(1)) {
        { pg8::Gemm g{XN, W_IN, MT, 2304, 1024}; pg8::StaticOrder S; S.init(MT, 2304, G, bx); Epi1 E{QF, KF, VF, CQR, ZS, SSQQ, out};
          pg8::gemm_phase<Epi1, pg8::StaticOrder, true, true>(lds, g, S, E); }
        { pg8::Gemm g{MN, W_MKV, 4096, 1024, 1024}; pg8::StaticOrder S; S.init(4096, 1024, G, (bx + 64) % G); EpiM E{MEMK, MEMV, out};
          pg8::gemm_phase<EpiM, pg8::StaticOrder, true, true>(lds, g, S, E); }
    }
    SEAM(1);
    if (IN(2)) {
        FRESH_TID();
        for (int r0 = gw * 4; r0 < MT; r0 += NGW * 4) {
            f32x4 v[4]; float x1[4], x2[4], fz[4];
#pragma unroll
            for (int k = 0; k < 4; ++k) { const float* z = ZS + (size_t)(r0 + k) * 384; v[k] = *(const f32x4*)(z + 4 * lane); x1[k] = 0.f; x2[k] = 0.f; fz[k] = 0.f;
                if (lane < 16) { x1[k] = z[256 + lane]; x2[k] = z[272 + lane]; } if (lane < 8) fz[k] = z[288 + lane]; }
            const f32x4 gkv = *(const f32x4*)(P.in[15] + 4 * lane); const float bf = (lane < 8) ? P.in[12][lane] : 0.f;
            float rs[4];
#pragma unroll
            for (int k = 0; k < 4; ++k) rs[k] = dot4(v[k]);
#pragma unroll
            for (int k = 0; k < 4; ++k) rs[k] = rsqrtf(wave_sum(rs[k]) * (1.0f / 256.0f) + EPS);
#pragma unroll
            for (int k = 0; k < 4; ++k) { const int r = r0 + k; const bool samp = r >= MP; const int orow = samp ? r - MP : r, kr = kvrow(r);
                const f32x4 ov = v[k] * rs[k] * gkv;
                *(f32x4*)(out + (samp ? OFF_S_CKV : OFF_P_CKV) + (size_t)orow * 256 + 4 * lane) = ov;
                *(u32x2*)(CKVB + (size_t)kr * 256 + 4 * lane) = pk4(ov);
                if (lane < 16) { const int pos = rowpos(r); const float c = COS[pos * 16 + lane], sn = SIN[pos * 16 + lane];
                    const float o1 = x1[k] * c - x2[k] * sn, o2 = x2[k] * c + x1[k] * sn; float* po = out + (samp ? OFF_S_KR : OFF_P_KR) + (size_t)orow * 32;
                    po[lane] = o1; po[lane + 16] = o2; bf16_t* pb = KRB + (size_t)kr * 32; pb[lane] = (bf16_t)(pk2(o1, 0.f) & 0xffffu); pb[lane + 16] = (bf16_t)(pk2(o2, 0.f) & 0xffffu); }
                if (lane < 8) { const float f = fz[k] + bf; const float lf = fminf(f, 0.f) - log1pf(__expf(-fabsf(f)));
                    out[(samp ? OFF_S_LOGF : OFF_P_LOGF) + (size_t)orow * 8 + lane] = lf; } }
        }
    }
    SEAM(2);
    if (IN(3)) {
        FRESH_TID();
        for (int job = bx; job < 24; job += G) {
            LAS float* TS = (LAS float*)lds; const bool samp = job >= 16; const int sb = job - 16, nthr = samp ? 264 : 512;
            const float* src; if (!samp) src = out + OFF_P_LOGF + ((size_t)job * 4096 + tid * 8) * 8; else if (tid < 256) src = P.in[5] + ((size_t)sb * 2048 + tid * 8) * 8; else src = out + OFF_S_LOGF + ((size_t)sb * 64 + (tid - 256) * 8) * 8;
            float s[8];
#pragma unroll
            for (int k = 0; k < 8; ++k) s[k] = 0.f;
            if (tid < nthr) {
#pragma unroll
                for (int r = 0; r < 8; ++r) { const f32x4 a = *(const f32x4*)(src + r * 8), b = *(const f32x4*)(src + r * 8 + 4);
                    s[0] += a[0]; s[1] += a[1]; s[2] += a[2]; s[3] += a[3]; s[4] += b[0]; s[5] += b[1]; s[6] += b[2]; s[7] += b[3]; }
            }
#pragma unroll
            for (int k = 0; k < 8; ++k) TS[tid * 8 + k] = s[k];
            __syncthreads();
            { float part = 0.f, loc[8];
#pragma unroll
                for (int k = 0; k < 8; ++k) { loc[k] = part; part += TS[(lane * 8 + k) * 8 + wid]; }
                float inc = part;
#pragma unroll
                for (int o = 1; o < 64; o <<= 1) { const float t = __shfl_up(inc, o); if (lane >= o) inc += t; }
                const float exc = inc - part;
#pragma unroll
                for (int k = 0; k < 8; ++k) TS[(lane * 8 + k) * 8 + wid] = exc + loc[k]; }
            __syncthreads();
            if (tid < nthr) {
#pragma unroll
                for (int k = 0; k < 8; ++k) s[k] = TS[tid * 8 + k];
                float* dst = CUM + ((size_t)(samp ? MP + sb * SKV : job * 4096) + tid * 8) * 8;
#pragma unroll
                for (int r = 0; r < 8; ++r) { const f32x4 a = *(const f32x4*)(src + r * 8), b = *(const f32x4*)(src + r * 8 + 4);
                    s[0] += a[0]; s[1] += a[1]; s[2] += a[2]; s[3] += a[3]; s[4] += b[0]; s[5] += b[1]; s[6] += b[2]; s[7] += b[3];
                    *(f32x4*)(dst + r * 8) = (f32x4){s[0], s[1], s[2], s[3]} * LOG2E; *(f32x4*)(dst + r * 8 + 4) = (f32x4){s[4], s[5], s[6], s[7]} * LOG2E; }
            }
            __syncthreads();
        }
        { pg8::Gemm g{CQR, W_UQ, MT, 768, 384}; pg8::StaticOrder S; S.init(MT, 768, G, bx); EpiScale E{MQ, 768, SSQQ, 1.0f / 384.0f, QS_MLA};
          pg8::gemm_phase<EpiScale, pg8::StaticOrder, true, true>(lds, g, S, E); }
        { pg8::Gemm g{CKVB, W_UKV, KVR, 1024, 256}; pg8::StaticOrder S; S.init(KVR, 1024, G, bx); Epi3 E{MKN, MV};
          pg8::gemm_phase<Epi3, pg8::StaticOrder, true, true>(lds, g, S, E); }
    }
    SEAM(3);
    if (IN(4)) {
        for (int uu = vcu; uu < 4224; uu += G) {
            AttnUnit d; bool mla; d.ROPE = COS;
            if (uu < 4096) {
                mla = uu >= 2048; const int u2 = uu & 2047, i = u2 >> 8, c = u2 & 255, bh = c >> 1, b = bh >> 3, h = bh & 7, qb = 2 * i + ((i & 1) ^ (c & 1));
                const size_t seq0 = (size_t)b * 4096, q0 = seq0 + qb * 256;
                d.nrows = 256; d.qpos0 = qb * 256; d.NT = (qb + 1) * 4;
                if (!mla) { d.Q = QF + q0 * 512 + h * 64; d.ldq = 512; d.K = KF + seq0 * 512 + h * 64; d.ldk = 512; d.K2 = nullptr; d.V = VF + seq0 * 512 + h * 64; d.ldv = 512; d.CK = CUM + seq0 * 8 + h; d.O = ATT + q0 * 1024 + h * 64; d.ldo = 1024; }
                else { d.Q = MQ + q0 * 768 + h * 96; d.ldq = 768; d.K = MKN + seq0 * 512 + h * 64; d.ldk = 512; d.K2 = KRB + seq0 * 32; d.V = MV + seq0 * 512 + h * 64; d.ldv = 512; d.CK = nullptr; d.O = ATT + q0 * 1024 + 512 + h * 64; d.ldo = 1024; }
            } else {
                const int u2 = uu - 4096; mla = u2 >= 64; const int sb = (u2 & 63) >> 3, h = u2 & 7;
                const size_t seq0 = (size_t)MP + (size_t)sb * SKV, q0 = (size_t)MP + sb * 64;
                d.nrows = 64; d.qpos0 = PAST; d.NT = 33;
                if (!mla) { d.Q = QF + q0 * 512 + h * 64; d.ldq = 512; d.K = KF + seq0 * 512 + h * 64; d.ldk = 512; d.K2 = nullptr; d.V = VF + seq0 * 512 + h * 64; d.ldv = 512; d.CK = CUM + seq0 * 8 + h; d.O = ATT + q0 * 1024 + h * 64; d.ldo = 1024; }
                else { d.Q = MQ + q0 * 768 + h * 96; d.ldq = 768; d.K = MKN + seq0 * 512 + h * 64; d.ldk = 512; d.K2 = KRB + seq0 * 32; d.V = MV + seq0 * 512 + h * 64; d.ldv = 512; d.CK = nullptr; d.O = ATT + q0 * 1024 + 512 + h * 64; d.ldo = 1024; }
            }
            if (wid < 4) { if (!mla) attn_unit_pipe<64, 64, 0, 0>(d, lds); else attn_unit_pipe<96, 64, 1, 0>(d, lds); }
            else         { if (!mla) attn_unit_pipe<64, 64, 0, 1>(d, lds); else attn_unit_pipe<96, 64, 1, 1>(d, lds); }
        }
    }
    SEAM(4);
    if (IN(5)) {
        FRESH_TID();
        for (int r0 = gw * 4; r0 < MT; r0 += NGW * 4) {
            bf16_t* a = ATT + (size_t)r0 * 1024; u32x4 w[8];
#pragma unroll
            for (int q = 0; q < 8; ++q) w[q] = *(const u32x4*)(a + (q >> 1) * 1024 + (q & 1) * 512 + lane * 8);
            float ss[8];
#pragma unroll
            for (int q = 0; q < 8; ++q) { float t = 0.f;
#pragma unroll
                for (int k = 0; k < 4; ++k) { const float xl = __uint_as_float(w[q][k] << 16), xh = __uint_as_float(w[q][k] & 0xffff0000u); t += xl * xl + xh * xh; }
                ss[q] = t; }
#pragma unroll
            for (int q = 0; q < 8; ++q) ss[q] = rsqrtf(wave_sum(ss[q]) * (1.0f / 512.0f) + EPS);
#pragma unroll
            for (int q = 0; q < 8; ++q) { const float* g = P.in[17 + (q & 1)] + lane * 8; const f32x4 g0 = *(const f32x4*)g, g1 = *(const f32x4*)(g + 4); const float rstd = ss[q]; float x[8];
#pragma unroll
                for (int k = 0; k < 4; ++k) { x[2 * k] = __uint_as_float(w[q][k] << 16); x[2 * k + 1] = __uint_as_float(w[q][k] & 0xffff0000u); }
                *(u32x4*)(a + (q >> 1) * 1024 + (q & 1) * 512 + lane * 8) = (u32x4){pk2(x[0] * rstd * g0[0], x[1] * rstd * g0[1]), pk2(x[2] * rstd * g0[2], x[3] * rstd * g0[3]),
                                                                                    pk2(x[4] * rstd * g1[0], x[5] * rstd * g1[1]), pk2(x[6] * rstd * g1[2], x[7] * rstd * g1[3])}; }
        }
    }
    SEAM(5);
    if (IN(6)) {
        pg8::Gemm g{ATT, W_O, MT, 1024, 1024}; pg8::StaticOrder S; S.init(MT, 1024, G, bx); EpiRes<true> E{P.in[0], P.in[1], out, XB, SSQ1};
        pg8::gemm_phase<EpiRes<true>, pg8::StaticOrder, true, true>(lds, g, S, E);
    }
    SEAM(6);
    if (IN(7)) {
        pg8::Gemm g{XB, W_MQ, MT, 512, 1024}; pg8::StaticOrder S; S.init(MT, 512, G, bx); EpiScale E{CQ, 512, SSQ1, 1.0f / 1024.0f, QS_MEM};
        pg8::gemm_phase<EpiScale, pg8::StaticOrder, true, true>(lds, g, S, E);
    }
    SEAM(7);
    if (IN(8)) {
        for (int uu = vcu; uu < 1024 + 32; uu += G) {
            AttnUnit d; d.ROPE = nullptr; d.K2 = nullptr; d.CK = nullptr; d.qpos0 = 0; d.NT = 4; d.ldq = 512; d.ldk = 512; d.ldv = 512; d.ldo = 512;
            if (uu < 1024) { const int rb = uu >> 2, h = uu & 3, b = rb >> 4; const size_t q0 = (size_t)rb * 256;
                d.nrows = 256; d.Q = CQ + q0 * 512 + h * 128; d.O = CO + q0 * 512 + h * 128; d.K = MEMK + (size_t)b * 256 * 512 + h * 128; d.V = MEMV + (size_t)b * 256 * 512 + h * 128; }
            else { const int u2 = uu - 1024, sb = u2 >> 2, h = u2 & 3; const size_t q0 = (size_t)MP + sb * 64;
                d.nrows = 64; d.Q = CQ + q0 * 512 + h * 128; d.O = CO + q0 * 512 + h * 128; d.K = MEMK + (size_t)(16 + sb) * 256 * 512 + h * 128; d.V = MEMV + (size_t)(16 + sb) * 256 * 512 + h * 128; }
            attn_unit<128, 128, 2>(d, lds);
        }
    }
    SEAM(8);
    if (IN(9)) {
        pg8::Gemm g{CO, W_MO, MT, 1024, 512}; pg8::StaticOrder S; S.init(MT, 1024, G, bx); EpiRes<true> E{out, out + (size_t)MP * 1024, out, XB, SSQ2};
        pg8::gemm_phase<EpiRes<true>, pg8::StaticOrder, true, true>(lds, g, S, E);
    }
    SEAM(9);
    if (IN(10)) {
        pg8::Gemm g{XB, W_GU, MT, 5632, 1024}; pg8::StaticOrder S; S.init(MT, 5632, G, bx); EpiGLU E{HB, SSQ2};
        pg8::gemm_phase<EpiGLU, pg8::StaticOrder, true, true>(lds, g, S, E);
    }
    SEAM(10);
    if (IN(11)) {
        pg8::Gemm g{HB, W_D, MT, 1024, 2816}; pg8::StaticOrder S; S.init(MT, 1024, G, bx); EpiRes<false> E{out, out + (size_t)MP * 1024, out, nullptr, SSQ3};
        pg8::gemm_phase<EpiRes<false>, pg8::StaticOrder, true, true>(lds, g, S, E);
    }
    SEAM(11);
    if (IN(12)) {
        FRESH_TID();
        for (int r0 = gw * 4; r0 < MT; r0 += NGW * 4) {
            float* y = out + (size_t)r0 * 1024; f32x4 v[16]; float rstd[4];
#pragma unroll
            for (int j = 0; j < 16; ++j) v[j] = ((const f32x4*)y)[lane + 64 * j];
#pragma unroll
            for (int k = 0; k < 4; ++k) rstd[k] = rsqrtf(SSQ3[r0 + k] * (1.0f / 1024.0f) + EPS);
#pragma unroll
            for (int j = 0; j < 16; ++j) { const f32x4 gg = ((const f32x4*)P.in[30])[lane + 64 * (j & 3)]; ((f32x4*)y)[lane + 64 * j] = v[j] * rstd[j >> 2] * gg; }
        }
    }
#undef IN
#undef SEAM
}

#ifndef N_LAUNCH_SPLIT
#define N_LAUNCH_SPLIT 0
#endif
extern "C" void kernel_launch(void* const* d_in, const int* in_sizes, int n_in, void* d_out, int out_size, void* d_ws, size_t ws_size, hipStream_t stream) {
    static int grid = 0;
    if (grid == 0) {
        if (n_in != 31 || (size_t)out_size != OUT_TOTAL || ws_size < WS_END) { fprintf(stderr, "kernel_launch: unexpected shapes: n_in %d out %d ws %zu\n", n_in, out_size, ws_size); grid = -1; return; }
        int dev = 0, cus = 0, per_cu = 0;
        hipGetDevice(&dev); hipDeviceGetAttribute(&cus, hipDeviceAttributeMultiprocessorCount, dev);
        if (hipFuncSetAttribute((const void*)fwd_kernel, hipFuncAttributeMaxDynamicSharedMemorySize, LDS_BYTES) != hipSuccess) { fprintf(stderr, "kernel_launch: hipFuncSetAttribute failed\n"); grid = -1; return; }
        if (hipOccupancyMaxActiveBlocksPerMultiprocessor(&per_cu, (const void*)fwd_kernel, NTHR, LDS_BYTES) != hipSuccess || per_cu < 1) { fprintf(stderr, "kernel_launch: occupancy query says %d\n", per_cu); per_cu = 1; }
        (void)hipGetLastError();
        grid = cus * (per_cu > 1 ? 1 : per_cu);
        fprintf(stderr, "kernel_launch: grid %d (cus %d, per_cu %d)\n", grid, cus, per_cu);
    }
    if (grid < 0) return;
    Params p{};
    for (int i = 0; i < 31; ++i) p.in[i] = (const float*)d_in[i];
    p.out = (float*)d_out; p.ws = (unsigned char*)d_ws;
#if N_LAUNCH_SPLIT
    for (int ph = 0; ph < 13; ++ph) { p.ph_lo = ph; p.ph_hi = ph + 1; hipLaunchKernelGGL(fwd_kernel, dim3(grid), dim3(NTHR), LDS_BYTES, stream, p); }
#else
    p.ph_lo = 0; p.ph_hi = 13;
    if (hipMemsetAsync((char*)d_ws + WS_CTL, 0, CTL_BYTES, stream) != hipSuccess) { fprintf(stderr, "kernel_launch: memset failed\n"); return; }
    void* args[] = {&p};
    hipError_t e = hipLaunchCooperativeKernel((const void*)fwd_kernel, dim3(grid), dim3(NTHR), args, LDS_BYTES, stream);
    if (e != hipSuccess) fprintf(stderr, "kernel_launch: cooperative launch failed: %s (grid %d)\n", hipGetErrorString(e), grid);
#endif
}
```

```cpp
#include <hip/hip_runtime.h>
#include <hip/hip_cooperative_groups.h>
#include <cstdio>
#include <cstdint>
namespace cg = cooperative_groups;
namespace pg8 {
#define PG8_LAS __attribute__((address_space(3)))
typedef unsigned short bf16_t;
typedef short bf16x8 __attribute__((ext_vector_type(8)));
typedef float f32x4 __attribute__((ext_vector_type(4)));
typedef unsigned u32x4 __attribute__((ext_vector_type(4)));
constexpr int BM = 256, BK = 64, HALF = 128, HTB = HALF * BK * 2  , STAGE_BYTES = 8 * HTB, NXCD = 8, WGM = 8;

__host__ __device__ __forceinline__ int lds_byte(int r, int c) { const int st = (r >> 4) * 2 + (c >> 5), rr = r & 15, cc = c & 31, ob = rr * 64 + cc * 2; return st * 1024 + (ob ^ (((ob >> 9) & 1) << 5)); }
__host__ __device__ __forceinline__ void stage_rc(int b, int& R, int& C) { const int st = b / 1024, sb = b % 1024, swz = sb ^ (((sb >> 9) & 1) << 5); R = (st >> 1) * 16 + swz / 64; C = (st & 1) * 32 + (swz % 64) / 2; }
__host__ __device__ __forceinline__ int perm32(int rho) { const int n = rho >> 4, i = rho & 15; return 8 * (i >> 2) + 4 * n + (i & 3); }

struct Unit { int pm, pn; };
struct Gemm { const bf16_t* A; const bf16_t* Bt; int M, N, K; };

struct StaticOrder {
    int nM, nN, nwg, G, c;
    __host__ __device__ void init(int M, int N, int G_, int c_) { nM = M / BM; nN = N / BM; nwg = nM * nN; G = G_; c = c_; }
    __host__ __device__ bool next(int i, Unit& u) const {
        const long L = (long)i * G + c; if (L >= nwg) return false;
        int wgid = (int)L; { const int q = nwg / NXCD, r = nwg % NXCD, xcd = wgid % NXCD, off = wgid / NXCD; wgid = (xcd < r ? xcd * (q + 1) : r * (q + 1) + (xcd - r) * q) + off; }
        const int nig = WGM * nN, gid = wgid / nig, fm = gid * WGM, gsz = (nM - fm) < WGM ? (nM - fm) : WGM;
        u.pm = fm + ((wgid % nig) % gsz); u.pn = (wgid % nig) / gsz; return true;
    }
    __device__ __forceinline__ void a_ready(const Unit&) const {}
    __device__ __forceinline__ void done(const Unit&) const {}
};

template <class Epi, class Sched, bool ALIGN_EPI = false, bool SP2 = false>
__device__ __forceinline__ void gemm_phase(PG8_LAS unsigned char* lds, const Gemm g, const Sched& S, const Epi& E) {
    int tid_ = threadIdx.x; asm volatile("" : "+v"(tid_)); const int tid = tid_, wid = __builtin_amdgcn_readfirstlane(tid >> 6), lane = tid & 63, wr = wid >> 2, wc = wid & 3, fr = lane & 15, fq = lane >> 4;
    const int K = g.K, nt = K / BK;
    unsigned voffA[2], voffB[2];
#pragma unroll
    for (int i = 0; i < 2; ++i) { int R, C; stage_rc(tid * 16 + i * 8192, R, C); const int Rb = Epi::PERM ? ((R & ~31) + perm32(R & 31)) : R;
        voffA[i] = (unsigned)(R * K + C) * 2u; voffB[i] = (unsigned)(Rb * K + C) * 2u; }
    const size_t kstep = (size_t)(BK * 2);
    const size_t hstep = (size_t)HALF * K * 2;
    const size_t tstep = 2 * hstep;
    const unsigned ldsw = (unsigned)wid * 1024u;
    const int aoff = lds_byte(wr * 64 + fr, fq * 8), boff = lds_byte(wc * 32 + fr, fq * 8);
#define PG8_SA(b, h) (((b) * 2 + (h)) * HTB)
#define PG8_SB(b, h) ((4 + (b) * 2 + (h)) * HTB)
#define PG8_STAGE(bufoff, gbase, voff) do { _Pragma("unroll") for (int _i = 0; _i < 2; ++_i) \
        __builtin_amdgcn_global_load_lds((const unsigned*)((const char*)(gbase) + (voff)[_i]), (PG8_LAS unsigned*)(lds + (bufoff) + ldsw + _i * 8192), 16, 0, 0); } while (0)
#define PG8_LDA(dst, b, h) do { _Pragma("unroll") for (int m = 0; m < 4; ++m) _Pragma("unroll") for (int k = 0; k < 2; ++k) dst[m][k] = *(const PG8_LAS bf16x8*)(lds + PG8_SA(b, h) + aoff + m * 2048 + k * 1024); } while (0)
#define PG8_LDB(dst, b, h) do { _Pragma("unroll") for (int n = 0; n < 2; ++n) _Pragma("unroll") for (int k = 0; k < 2; ++k) dst[n][k] = *(const PG8_LAS bf16x8*)(lds + PG8_SB(b, h) + boff + n * 2048 + k * 1024); } while (0)
#define PG8_MMA(ai, bj, At, Bt) do { __builtin_amdgcn_s_setprio(1); _Pragma("unroll") for (int m = 0; m < 4; ++m) _Pragma("unroll") for (int n = 0; n < 2; ++n) _Pragma("unroll") for (int k = 0; k < 2; ++k) \
        acc[ai][bj][m][n] = __builtin_amdgcn_mfma_f32_16x16x32_bf16(Bt[n][k], At[m][k], acc[ai][bj][m][n], 0, 0, 0); __builtin_amdgcn_s_setprio(0); } while (0)
#define PG8_WAIT_V(n) asm volatile("s_waitcnt vmcnt(" #n ")" ::: "memory")
#define PG8_WAIT_L(n) asm volatile("s_waitcnt lgkmcnt(" #n ")" ::: "memory")
#define PG8_BAR __builtin_amdgcn_s_barrier()
#define PG8_SCHED __builtin_amdgcn_sched_barrier(0)
    Unit cur, nxt; int ui = 0;
    if (!S.next(0, cur)) return;
    f32x4 acc[2][2][4][2];
#pragma unroll
    for (int a = 0; a < 2; ++a)
#pragma unroll
        for (int b = 0; b < 2; ++b)
#pragma unroll
            for (int m = 0; m < 4; ++m)
#pragma unroll
                for (int n = 0; n < 2; ++n) acc[a][b][m][n] = (f32x4){0.f, 0.f, 0.f, 0.f};
    bf16x8 At[4][2], B0[2][2], B1[2][2];
    const char* cA = (const char*)g.A + (size_t)cur.pm * tstep; const char* cB = (const char*)g.Bt + (size_t)cur.pn * tstep;
    S.a_ready(cur);
    if constexpr (SP2) {
        PG8_STAGE(PG8_SB(0, 0), cB, voffB); PG8_STAGE(PG8_SB(0, 1), cB + hstep, voffB); PG8_STAGE(PG8_SA(0, 0), cA, voffA); PG8_STAGE(PG8_SA(0, 1), cA + hstep, voffA);
        if (wr == 1) PG8_BAR;
        PG8_WAIT_V(2); PG8_BAR;
        PG8_STAGE(PG8_SB(1, 0), cB + kstep, voffB); PG8_STAGE(PG8_SA(1, 0), cA + kstep, voffA); PG8_STAGE(PG8_SB(1, 1), cB + hstep + kstep, voffB);
        PG8_WAIT_V(6); PG8_BAR;
    } else {
        PG8_STAGE(PG8_SB(0, 0), cB, voffB); PG8_STAGE(PG8_SA(0, 0), cA, voffA); PG8_STAGE(PG8_SB(0, 1), cB + hstep, voffB); PG8_STAGE(PG8_SA(0, 1), cA + hstep, voffA);
        if (wr == 1) PG8_BAR;
        PG8_WAIT_V(4); PG8_BAR;
        PG8_STAGE(PG8_SB(1, 0), cB + kstep, voffB); PG8_STAGE(PG8_SA(1, 0), cA + kstep, voffA); PG8_STAGE(PG8_SB(1, 1), cB + hstep + kstep, voffB);
        PG8_WAIT_V(6); PG8_BAR;
    }
    for (;;) {
        const bool has_next = S.next(ui + 1, nxt);
        const char* nA = has_next ? (const char*)g.A + (size_t)nxt.pm * tstep : cA; const char* nB = has_next ? (const char*)g.Bt + (size_t)nxt.pn * tstep : cB;
        for (int t = 0; t < nt; t += 2) {
            const bool last = (t == nt - 2);
            const char* a1 = cA + (size_t)(t + 1) * kstep;
            const char* a2 = last ? nA : cA + (size_t)(t + 2) * kstep; const char* b2 = last ? nB : cB + (size_t)(t + 2) * kstep;
            const char* a3 = a2 + kstep; const char* b3 = b2 + kstep;
            if (last && has_next) S.a_ready(nxt);
            if constexpr (SP2) {
            PG8_LDB(B0, 0, 0); PG8_LDB(B1, 0, 1); PG8_SCHED; PG8_LDA(At, 0, 0); PG8_STAGE(PG8_SA(1, 1), a1 + hstep, voffA);
            PG8_WAIT_V(8); PG8_WAIT_L(0); PG8_BAR; PG8_MMA(0, 0, At, B0); PG8_MMA(0, 1, At, B1); PG8_BAR; PG8_SCHED;
            PG8_LDA(At, 0, 1); PG8_STAGE(PG8_SB(0, 0), b2, voffB); PG8_STAGE(PG8_SB(0, 1), b2 + hstep, voffB); PG8_STAGE(PG8_SA(0, 0), a2, voffA);
            PG8_WAIT_V(8); PG8_WAIT_L(0); PG8_BAR; PG8_MMA(1, 0, At, B0); PG8_MMA(1, 1, At, B1); PG8_BAR; PG8_SCHED;
            PG8_LDB(B0, 1, 0); PG8_LDB(B1, 1, 1); PG8_SCHED; PG8_LDA(At, 1, 0); PG8_STAGE(PG8_SA(0, 1), a2 + hstep, voffA);
            PG8_WAIT_V(8); PG8_WAIT_L(0); PG8_BAR; PG8_MMA(0, 0, At, B0); PG8_MMA(0, 1, At, B1); PG8_BAR; PG8_SCHED;
            PG8_LDA(At, 1, 1); PG8_STAGE(PG8_SB(1, 0), b3, voffB); PG8_STAGE(PG8_SB(1, 1), b3 + hstep, voffB); PG8_STAGE(PG8_SA(1, 0), a3, voffA);
            PG8_WAIT_V(8); PG8_WAIT_L(0); PG8_BAR; PG8_MMA(1, 0, At, B0); PG8_MMA(1, 1, At, B1); PG8_BAR; PG8_SCHED;
            } else {
            PG8_LDB(B0, 0, 0); PG8_SCHED; PG8_LDA(At, 0, 0); PG8_STAGE(PG8_SA(1, 1), a1 + hstep, voffA);
            PG8_WAIT_L(8); PG8_BAR; PG8_WAIT_L(0); PG8_MMA(0, 0, At, B0); PG8_BAR; PG8_SCHED;
            PG8_LDB(B1, 0, 1); PG8_STAGE(PG8_SB(0, 0), b2, voffB);
            PG8_BAR; PG8_WAIT_L(0); PG8_MMA(0, 1, At, B1); PG8_BAR;
            PG8_LDA(At, 0, 1); PG8_STAGE(PG8_SA(0, 0), a2, voffA);
            PG8_BAR; PG8_WAIT_L(0); PG8_MMA(1, 0, At, B0); PG8_BAR; PG8_SCHED;
            PG8_STAGE(PG8_SB(0, 1), b2 + hstep, voffB);
            PG8_WAIT_V(6); PG8_BAR; PG8_MMA(1, 1, At, B1); PG8_BAR;
            PG8_LDB(B0, 1, 0); PG8_SCHED; PG8_LDA(At, 1, 0); PG8_STAGE(PG8_SA(0, 1), a2 + hstep, voffA);
            PG8_WAIT_L(8); PG8_BAR; PG8_WAIT_L(0); PG8_MMA(0, 0, At, B0); PG8_BAR; PG8_SCHED;
            PG8_LDB(B1, 1, 1); PG8_STAGE(PG8_SB(1, 0), b3, voffB);
            PG8_BAR; PG8_WAIT_L(0); PG8_MMA(0, 1, At, B1); PG8_BAR;
            PG8_LDA(At, 1, 1); PG8_STAGE(PG8_SA(1, 0), a3, voffA);
            PG8_BAR; PG8_WAIT_L(0); PG8_MMA(1, 0, At, B0); PG8_BAR; PG8_SCHED;
            PG8_STAGE(PG8_SB(1, 1), b3 + hstep, voffB);
            PG8_WAIT_V(6); PG8_BAR; PG8_MMA(1, 1, At, B1); PG8_BAR;
            }
        }
        if constexpr (ALIGN_EPI) { if (wr == 0) PG8_BAR; }
        if constexpr (!Epi::AFTER_DRAIN) { E(acc, cur, wr, wc, fr, fq); S.done(cur); }
        if (!has_next) break;
#pragma unroll
        for (int a = 0; a < 2; ++a)
#pragma unroll
            for (int b = 0; b < 2; ++b)
#pragma unroll
                for (int m = 0; m < 4; ++m)
#pragma unroll
                    for (int n = 0; n < 2; ++n) acc[a][b][m][n] = (f32x4){0.f, 0.f, 0.f, 0.f};
        cur = nxt; cA = nA; cB = nB; ++ui;
        if constexpr (ALIGN_EPI) { if (wr == 1) PG8_BAR; }
    }
    PG8_WAIT_V(0);
    if constexpr (!ALIGN_EPI) { if (wr == 0) PG8_BAR; }
    PG8_BAR;
    if constexpr (Epi::AFTER_DRAIN) { E.fused(acc, cur, wr, wc, fr, fq, lds, wid, lane); S.done(cur); }
#undef PG8_SA
#undef PG8_SB
#undef PG8_STAGE
#undef PG8_LDA
#undef PG8_LDB
#undef PG8_MMA
#undef PG8_WAIT_V
#undef PG8_WAIT_L
#undef PG8_BAR
#undef PG8_SCHED
}
}

#define LAS __attribute__((address_space(3)))
typedef unsigned short bf16_t;
typedef short bf16x8 __attribute__((ext_vector_type(8)));
typedef short s16x4 __attribute__((ext_vector_type(4)));
typedef float f32x4 __attribute__((ext_vector_type(4)));
typedef float f32x2 __attribute__((ext_vector_type(2)));
typedef float f32x16 __attribute__((ext_vector_type(16)));
typedef unsigned u32x4 __attribute__((ext_vector_type(4)));
typedef unsigned u32x2 __attribute__((ext_vector_type(2)));
typedef __bf16 bf16x2_t __attribute__((ext_vector_type(2)));

constexpr int MP = 65536, MS = 512, MT = MP + MS, PAST = 2048, SKV = 2112, KVR = MP + 8 * SKV;
constexpr float EPS = 1e-6f, LOG2E = 1.4426950408889634f;
constexpr float QS_FOX = 0.125f * LOG2E, QS_MLA = 0.10206207261596575f * LOG2E, QS_MEM = 0.08838834764831845f * LOG2E;
constexpr int NTHR = 512;

constexpr size_t OFF_Y = 0;
constexpr size_t OFF_P_FOX_K = (size_t)MT * 1024;
constexpr size_t OFF_P_FOX_V = OFF_P_FOX_K + (size_t)MP * 512;
constexpr size_t OFF_P_LOGF = OFF_P_FOX_V + (size_t)MP * 512;
constexpr size_t OFF_P_CKV = OFF_P_LOGF + (size_t)MP * 8;
constexpr size_t OFF_P_KR = OFF_P_CKV + (size_t)MP * 256;
constexpr size_t OFF_P_MEM_K = OFF_P_KR + (size_t)MP * 32;
constexpr size_t OFF_P_MEM_V = OFF_P_MEM_K + (size_t)4096 * 512;
constexpr size_t OFF_S_FOX_K = OFF_P_MEM_V + (size_t)4096 * 512;
constexpr size_t OFF_S_FOX_V = OFF_S_FOX_K + (size_t)MS * 512;
constexpr size_t OFF_S_LOGF = OFF_S_FOX_V + (size_t)MS * 512;
constexpr size_t OFF_S_CKV = OFF_S_LOGF + (size_t)MS * 8;
constexpr size_t OFF_S_KR = OFF_S_CKV + (size_t)MS * 256;
constexpr size_t OUT_TOTAL = OFF_S_KR + (size_t)MS * 32;
static_assert(OUT_TOTAL == 159010816ull, "d_out map");

constexpr size_t MiB = 1u << 20;
constexpr size_t WS_W_IN = 0, WS_W_UQ = 5 * MiB, WS_W_UKV = 6 * MiB, WS_W_O = 7 * MiB, WS_W_MKV = 9 * MiB, WS_W_MQ = 11 * MiB, WS_W_MO = 12 * MiB,
                 WS_W_GU = 13 * MiB, WS_W_D = 24 * MiB, WS_ROPE = 30 * MiB, WS_SSQ = 31 * MiB, WS_CUM = 33 * MiB, WS_MEMK = 36 * MiB, WS_MEMV = 42 * MiB,
                 WS_MN = 48 * MiB, WS_XN = 56 * MiB  , WS_D = 185 * MiB;
constexpr size_t WS_ZS = WS_D, WS_QF = 282 * MiB, WS_KF = 347 * MiB, WS_VF = 428 * MiB, WS_CQR = 509 * MiB, WS_CKVB = 558 * MiB, WS_KRB = 599 * MiB,
                 WS_MQ = 605 * MiB, WS_MKN = 702 * MiB, WS_MV = 783 * MiB, WS_END = 864 * MiB;
constexpr size_t WS_CTL = 32 * MiB + 512 * 1024, CTL_BYTES = 16384;
constexpr size_t WS_XB = WS_D, WS_CQ = 314 * MiB, WS_CO = 379 * MiB, WS_H = 444 * MiB;
static_assert(WS_H + (size_t)MT * 2816 * 2 <= WS_END, "H overlay");
static_assert(WS_ZS + (size_t)MT * 384 * 4 <= WS_QF && WS_QF + (size_t)MT * 512 * 2 <= WS_KF && WS_KF + (size_t)KVR * 512 * 2 <= WS_VF && WS_VF + (size_t)KVR * 512 * 2 <= WS_CQR, "map1");
static_assert(WS_CQR + (size_t)MT * 384 * 2 <= WS_CKVB && WS_CKVB + (size_t)KVR * 256 * 2 <= WS_KRB && WS_KRB + (size_t)KVR * 32 * 2 <= WS_MQ && WS_MQ + (size_t)MT * 768 * 2 <= WS_MKN, "map2");
static_assert(WS_MKN + (size_t)KVR * 512 * 2 <= WS_MV && WS_MV + (size_t)KVR * 512 * 2 <= WS_END && WS_XN + (size_t)MT * 1024 * 2 <= WS_D, "map3");
static_assert(WS_XB + (size_t)MT * 1024 * 2 <= WS_CQ && WS_CQ + (size_t)MT * 512 * 2 <= WS_CO && WS_CO + (size_t)MT * 512 * 2 <= WS_H, "map4");

struct Params { const float* in[31]; float* out; unsigned char* ws; int ph_lo, ph_hi; };

__device__ __forceinline__ unsigned pk2(float lo, float hi) { f32x2 v = {lo, hi}; bf16x2_t b = __builtin_convertvector(v, bf16x2_t); return __builtin_bit_cast(unsigned, b); }
__device__ __forceinline__ u32x2 pk4(f32x4 v) { return (u32x2){pk2(v[0], v[1]), pk2(v[2], v[3])}; }
__device__ __forceinline__ float dot4(f32x4 v) { return (v[0] * v[0] + v[1] * v[1]) + (v[2] * v[2] + v[3] * v[3]); }
__device__ __forceinline__ float wave_sum(float v) {
#pragma unroll
    for (int o = 1; o < 64; o <<= 1) v += __shfl_xor(v, o);
    return v;
}
__device__ __forceinline__ int kvrow(int r) { return r < MP ? r : MP + ((r - MP) >> 6) * SKV + PAST + ((r - MP) & 63); }
__device__ __forceinline__ int rowpos(int r) { return r < MP ? (r & 4095) : PAST + ((r - MP) & 63); }
#define LDS_WAIT() asm volatile("s_waitcnt lgkmcnt(0)" ::: "memory")

__constant__ double ROPE_INV[16] = {1.0, 0.5623413251903491, 0.31622776601683794, 0.1778279410038923, 0.1, 0.05623413251903491, 0.031622776601683794, 0.01778279410038923,
                                    0.01, 0.005623413251903491, 0.0031622776601683794, 0.001778279410038923, 0.001, 0.0005623413251903491, 0.00031622776601683794, 0.0001778279410038923};

#define EPI_ARGS const pg8::f32x4 (&acc)[2][2][4][2], const pg8::Unit& u, int wr, int wc, int fr, int fq
#define FOR_AI_M _Pragma("unroll") for (int ai = 0; ai < 2; ++ai) _Pragma("unroll") for (int m = 0; m < 4; ++m)
#define FOR_BJ_N _Pragma("unroll") for (int bj = 0; bj < 2; ++bj) _Pragma("unroll") for (int n = 0; n < 2; ++n)

struct Epi1 {
    static constexpr bool PERM = false, AFTER_DRAIN = false;
    bf16_t *QF, *KF, *VF, *CQR; float *ZS, *SSQQ, *out;
    __device__ __forceinline__ void operator()(EPI_ARGS) const {
        const int pn = u.pn, row0 = u.pm * 256 + wr * 64 + fr, cw = wc * 32 + 4 * fq; const bool samp = u.pm >= 256;
        if (pn < 2) {
            FOR_AI_M { const int row = row0 + ai * 128 + m * 16; bf16_t* p = QF + (size_t)row * 512 + pn * 256 + cw;
                FOR_BJ_N { const f32x4 v = acc[ai][bj][m][n] * QS_FOX; *(u32x2*)(p + bj * 128 + n * 16) = pk4(v); } }
        } else if (pn < 6) {
            const bool isV = pn >= 4; bf16_t* B = isV ? VF : KF;
            float* O = out + (samp ? (isV ? OFF_S_FOX_V : OFF_S_FOX_K) : (isV ? OFF_P_FOX_V : OFF_P_FOX_K));
            const int cb = (pn & 1) * 256 + cw;
            FOR_AI_M { const int row = row0 + ai * 128 + m * 16, orow = samp ? row - MP : row, kr = kvrow(row);
                float* po = O + (size_t)orow * 512 + cb; bf16_t* pb = B + (size_t)kr * 512 + cb;
                FOR_BJ_N { const f32x4 v = acc[ai][bj][m][n]; *(f32x4*)(po + bj * 128 + n * 16) = v; *(u32x2*)(pb + bj * 128 + n * 16) = pk4(v); } }
        } else {
            FOR_AI_M { const int row = row0 + ai * 128 + m * 16; float ss = 0.f;
#pragma unroll
                for (int bj = 0; bj < 2; ++bj) { const int gc = pn * 256 + bj * 128;
                    if (gc < 1920) { bf16_t* p = CQR + (size_t)row * 384 + (gc - 1536) + cw;
#pragma unroll
                        for (int n = 0; n < 2; ++n) { const f32x4 v = acc[ai][bj][m][n]; *(u32x2*)(p + n * 16) = pk4(v); ss += dot4(v); } }
                    else { float* p = ZS + (size_t)row * 384 + (gc - 1920) + cw;
#pragma unroll
                        for (int n = 0; n < 2; ++n) *(f32x4*)(p + n * 16) = acc[ai][bj][m][n]; } }
                if (pn * 256 < 1920) { ss += __shfl_xor(ss, 16); ss += __shfl_xor(ss, 32); if (fq == 0) unsafeAtomicAdd(SSQQ + row, ss); } }
        }
    }
};
struct EpiM {
    static constexpr bool PERM = false, AFTER_DRAIN = false;
    bf16_t *MEMK, *MEMV; float* out;
    __device__ __forceinline__ void operator()(EPI_ARGS) const {
        const bool isV = u.pn >= 2; bf16_t* B = isV ? MEMV : MEMK; float* O = out + (isV ? OFF_P_MEM_V : OFF_P_MEM_K);
        const int row0 = u.pm * 256 + wr * 64 + fr, cb = (u.pn & 1) * 256 + wc * 32 + 4 * fq;
        FOR_AI_M { const int row = row0 + ai * 128 + m * 16; float* po = O + (size_t)row * 512 + cb; bf16_t* pb = B + (size_t)row * 512 + cb;
            FOR_BJ_N { const f32x4 v = acc[ai][bj][m][n]; *(f32x4*)(po + bj * 128 + n * 16) = v; *(u32x2*)(pb + bj * 128 + n * 16) = pk4(v); } }
    }
};
struct Epi3 {
    static constexpr bool PERM = false, AFTER_DRAIN = false;
    bf16_t *MKN, *MV;
    __device__ __forceinline__ void operator()(EPI_ARGS) const {
        bf16_t* B = (wc >= 2) ? MV : MKN; const int cw = (wc & 1) * 32 + 4 * fq, row0 = u.pm * 256 + wr * 64 + fr;
        FOR_AI_M { const int row = row0 + ai * 128 + m * 16;
            FOR_BJ_N { bf16_t* p = B + (size_t)row * 512 + (2 * u.pn + bj) * 64 + cw + n * 16; *(u32x2*)p = pk4(acc[ai][bj][m][n]); } }
    }
};
template <bool XB_OUT, bool Y_OUT, bool BASE_BF16> struct EpiRes {
    static constexpr bool PERM = false, AFTER_DRAIN = false;
    const float *bp, *bs; float* Y; bf16_t* XB; float* SSQ;
    __device__ __forceinline__ void operator()(EPI_ARGS) const {
        const int row0 = u.pm * 256 + wr * 64 + fr, cb = u.pn * 256 + wc * 32 + 4 * fq;
        FOR_AI_M { const int row = row0 + ai * 128 + m * 16;
            const float* b = (u.pm >= 256) ? bs + (size_t)(row - MP) * 1024 : bp + (size_t)row * 1024; float* y = Y + (size_t)row * 1024; bf16_t* xb = XB + (size_t)row * 1024; float ss = 0.f;
            FOR_BJ_N { const int off = cb + bj * 128 + n * 16; f32x4 base;
                if (BASE_BF16) { const u32x2 w = *(const u32x2*)(xb + off); base = (f32x4){__uint_as_float(w[0] << 16), __uint_as_float(w[0] & 0xffff0000u), __uint_as_float(w[1] << 16), __uint_as_float(w[1] & 0xffff0000u)}; }
                else base = *(const f32x4*)(b + off);
                const f32x4 v = acc[ai][bj][m][n] + base;
                if (Y_OUT) *(f32x4*)(y + off) = v;
                if (XB_OUT) *(u32x2*)(xb + off) = pk4(v); ss += dot4(v); }
            ss += __shfl_xor(ss, 16); ss += __shfl_xor(ss, 32); if (fq == 0) unsafeAtomicAdd(SSQ + row, ss);
            asm volatile("" ::: "memory"); }
    }
};
struct EpiScale {
    static constexpr bool PERM = false, AFTER_DRAIN = false;
    bf16_t* O; int ldo; const float* SSQ; float inv_n, qs;
    __device__ __forceinline__ void operator()(EPI_ARGS) const {
        const int row0 = u.pm * 256 + wr * 64 + fr, cb = u.pn * 256 + wc * 32 + 4 * fq;
        FOR_AI_M { const int row = row0 + ai * 128 + m * 16; const float rs = rsqrtf(SSQ[row] * inv_n + EPS) * qs; bf16_t* p = O + (size_t)row * ldo + cb;
            FOR_BJ_N { *(u32x2*)(p + bj * 128 + n * 16) = pk4(acc[ai][bj][m][n] * rs); } }
    }
};
struct EpiGLU {
    static constexpr bool PERM = false, AFTER_DRAIN = false;
    bf16_t* H; const float* SSQ;
    __device__ __forceinline__ void operator()(EPI_ARGS) const {
        const int row0 = u.pm * 256 + wr * 64 + fr, cb = u.pn * 128 + wc * 32 + 4 * fq;
        FOR_AI_M { const int row = row0 + ai * 128 + m * 16; const float rs = rsqrtf(SSQ[row] * (1.0f / 1024.0f) + EPS); bf16_t* p = H + (size_t)row * 2816 + cb;
#pragma unroll
            for (int n = 0; n < 2; ++n) { const f32x4 g = acc[ai][0][m][n] * rs, uu = acc[ai][1][m][n] * rs; f32x4 h;
#pragma unroll
                for (int e = 0; e < 4; ++e) h[e] = g[e] * uu[e] * __builtin_amdgcn_rcpf(1.0f + __builtin_amdgcn_exp2f(-g[e] * LOG2E));
                *(u32x2*)(p + n * 16) = pk4(h); } }
    }
};

struct AttnUnit {
    const bf16_t* Q; int ldq;
    const bf16_t* K; int ldk;
    const bf16_t* K2;
    const bf16_t* V; int ldv;
    const float* CK;
    const float* ROPE;
    bf16_t* O; int ldo;
    int nrows, qpos0, NT;
};
__device__ __forceinline__ int crow(int r, int hi) { return (r & 3) + 8 * (r >> 2) + 4 * hi; }
__device__ __forceinline__ s16x4 vtr(const LAS unsigned char* p) {
    typedef short v4i16_t __attribute__((ext_vector_type(4)));
    return __builtin_bit_cast(s16x4, __builtin_amdgcn_ds_read_tr16_b64_v4i16((LAS v4i16_t*)p));
}
template <int DK, int DV, int MODE>
__device__ __forceinline__ void attn_unit(const AttnUnit& d, LAS unsigned char* lds) {
    constexpr int DKM = (MODE == 1) ? 64 : DK;
    constexpr int KS = DK * 2 + 16;
    constexpr int NKC = DKM / 64, NVC = DV / 64, VSUB = DV / 32, CPRK = DKM / 8, CPRV = DV / 8;
    constexpr int KB0 = 0, KBS = 17408, VB0 = 34816, VBS = 16384, CKO = 67584;
    int tid_ = threadIdx.x; asm volatile("" : "+v"(tid_)); const int tid = tid_, lane = tid & 63, wid = __builtin_amdgcn_readfirstlane(tid >> 6), r32 = lane & 31, hi = lane >> 5;
    const bool wact = (wid * 32 < d.nrows);
    const int qpw = d.qpos0 + wid * 32;
    int tmax = (MODE == 0) ? ((qpw + 31) >> 6) : (MODE == 1) ? (qpw >> 6) : (d.NT - 1);
    if (!wact) tmax = -1;
    const int NT = d.NT;
    bf16x8 qf[DK / 16];
    {
        const bf16_t* qp = d.Q + (size_t)((wact ? wid * 32 : 0) + r32) * d.ldq + hi * 8;
#pragma unroll
        for (int ks = 0; ks < DK / 16; ++ks) qf[ks] = *(const bf16x8*)(qp + ks * 16);
    }
    if (MODE == 1) {
        const int pos = (wact ? qpw : d.qpos0) + r32; const float* cp = d.ROPE + pos * 16 + hi * 8;
        const f32x4 c0 = *(const f32x4*)cp, c1 = *(const f32x4*)(cp + 4), s0 = *(const f32x4*)(cp + 65536), s1 = *(const f32x4*)(cp + 65540);
        const u32x4 a = __builtin_bit_cast(u32x4, qf[4]), b = __builtin_bit_cast(u32x4, qf[5]); u32x4 oa, ob;
#pragma unroll
        for (int k = 0; k < 4; ++k) {
            const float x1l = __uint_as_float(a[k] << 16), x1h = __uint_as_float(a[k] & 0xffff0000u), x2l = __uint_as_float(b[k] << 16), x2h = __uint_as_float(b[k] & 0xffff0000u);
            const float cl = (k < 2) ? c0[2 * k] : c1[2 * k - 4], ch = (k < 2) ? c0[2 * k + 1] : c1[2 * k - 3], sl = (k < 2) ? s0[2 * k] : s1[2 * k - 4], sh = (k < 2) ? s0[2 * k + 1] : s1[2 * k - 3];
            oa[k] = pk2(x1l * cl - x2l * sl, x1h * ch - x2h * sh); ob[k] = pk2(x2l * cl + x1l * sl, x2h * ch + x1h * sh);
        }
        qf[4] = __builtin_bit_cast(bf16x8, oa); qf[5] = __builtin_bit_cast(bf16x8, ob);
    }
    float cq = 0.f;
    if (MODE == 0) cq = d.CK[(size_t)((wact ? qpw : d.qpos0) + r32) * 8];
    struct Stage { u32x4 k[NKC]; u32x4 v[NVC]; u32x4 k2; float ck; };
    Stage sg0, sg1; sg0.k2 = (u32x4){0u, 0u, 0u, 0u}; sg1.k2 = sg0.k2; sg0.ck = 0.f; sg1.ck = 0.f;
#define ATT_LOAD(t, SG) do { \
        _Pragma("unroll") for (int i_ = 0; i_ < NKC; ++i_) { const int id_ = tid + 512 * i_, row_ = id_ / CPRK, c_ = id_ % CPRK; \
            SG.k[i_] = *(const u32x4*)(d.K + (size_t)((t) * 64 + row_) * d.ldk + c_ * 8); } \
        _Pragma("unroll") for (int i_ = 0; i_ < NVC; ++i_) { const int id_ = tid + 512 * i_, row_ = id_ / CPRV, c_ = id_ % CPRV; \
            SG.v[i_] = *(const u32x4*)(d.V + (size_t)((t) * 64 + row_) * d.ldv + c_ * 8); } \
        if (MODE == 1) { if (tid < 256) SG.k2 = *(const u32x4*)(d.K2 + (size_t)((t) * 64 + (tid >> 2)) * 32 + (tid & 3) * 8); } \
        if (MODE == 0) { if (tid < 64) SG.ck = d.CK[(size_t)((t) * 64 + tid) * 8]; } } while (0)
#define ATT_STORE(buf, SG) do { \
        _Pragma("unroll") for (int i_ = 0; i_ < NKC; ++i_) { const int id_ = tid + 512 * i_, row_ = id_ / CPRK, c_ = id_ % CPRK; \
            *(LAS u32x4*)(lds + KB0 + (buf) * KBS + row_ * KS + c_ * 16) = SG.k[i_]; } \
        _Pragma("unroll") for (int i_ = 0; i_ < NVC; ++i_) { const int id_ = tid + 512 * i_, row_ = id_ / CPRV, c_ = id_ % CPRV; \
            *(LAS u32x4*)(lds + VB0 + (buf) * VBS + ((row_ >> 3) * VSUB + (c_ >> 2)) * 512 + (row_ & 7) * 64 + (c_ & 3) * 16) = SG.v[i_]; } \
        if (MODE == 1) { if (tid < 256) *(LAS u32x4*)(lds + KB0 + (buf) * KBS + (tid >> 2) * KS + 128 + (tid & 3) * 16) = SG.k2; } \
        if (MODE == 0) { if (tid < 64) *(LAS float*)(lds + CKO + (buf) * 256 + tid * 4) = SG.ck; } } while (0)
#define ATT_BAR() do { asm volatile("s_waitcnt lgkmcnt(0)" ::: "memory"); __builtin_amdgcn_s_barrier(); asm volatile("" ::: "memory"); } while (0)
    f32x16 o[VSUB], negm;
#pragma unroll
    for (int db = 0; db < VSUB; ++db)
#pragma unroll
        for (int i = 0; i < 16; ++i) o[db][i] = 0.f;
#pragma unroll
    for (int i = 0; i < 16; ++i) negm[i] = 0.f;
    float mst = 0.f, lrun = 0.f;
    constexpr float THR = 8.0f;
    ATT_LOAD(NT - 1, sg0); ATT_STORE(0, sg0);
    if (NT > 1) ATT_LOAD(NT - 2, sg1);
    if (NT > 2) ATT_LOAD(NT - 3, sg0);
    ATT_BAR();
    for (int j = 0; j < NT; ++j) {
        const int buf = j & 1, t = NT - 1 - j;
        if (t <= tmax) {
            const bool first = (t == tmax);
            f32x16 s[2];
            if (MODE == 0) {
                const float base = cq - mst;
#pragma unroll
                for (int sb = 0; sb < 2; ++sb)
#pragma unroll
                    for (int g = 0; g < 4; ++g) { const f32x4 ck = *(const LAS f32x4*)(lds + CKO + buf * 256 + (sb * 32 + 8 * g + 4 * hi) * 4);
#pragma unroll
                        for (int e = 0; e < 4; ++e) s[sb][4 * g + e] = base - ck[e]; }
            } else { s[0] = negm; s[1] = negm; }
            {
                const LAS unsigned char* kp = lds + KB0 + buf * KBS + r32 * KS + hi * 16;
#pragma unroll
                for (int ks = 0; ks < DK / 16; ++ks) {
                    const bf16x8 a0 = *(const LAS bf16x8*)(kp + ks * 32), a1 = *(const LAS bf16x8*)(kp + 32 * KS + ks * 32);
                    s[0] = __builtin_amdgcn_mfma_f32_32x32x16_bf16(a0, qf[ks], s[0], 0, 0, 0);
                    s[1] = __builtin_amdgcn_mfma_f32_32x32x16_bf16(a1, qf[ks], s[1], 0, 0, 0);
                }
            }
            if (MODE == 0) {
                if (t * 64 + 63 > qpw) {
                    const int qp = qpw + r32;
#pragma unroll
                    for (int sb = 0; sb < 2; ++sb)
#pragma unroll
                        for (int i = 0; i < 16; ++i) { const int kvp = t * 64 + sb * 32 + crow(i, hi); if (kvp > qp) s[sb][i] = -1e30f; }
                }
            }
            float rm = fmaxf(fmaxf(s[0][0], s[0][1]), s[0][2]);
#pragma unroll
            for (int i = 3; i < 15; i += 2) rm = fmaxf(fmaxf(rm, s[0][i]), s[0][i + 1]);
            rm = fmaxf(fmaxf(rm, s[0][15]), s[1][0]);
#pragma unroll
            for (int i = 1; i < 15; i += 2) rm = fmaxf(fmaxf(rm, s[1][i]), s[1][i + 1]);
            rm = fmaxf(rm, s[1][15]);
            { auto rr = __builtin_amdgcn_permlane32_swap(__float_as_uint(rm), __float_as_uint(rm), false, false); rm = fmaxf(__uint_as_float(rr[0]), __uint_as_float(rr[1])); }
            if (first || __any(rm > THR)) {
                const float dl = first ? rm : fmaxf(rm, 0.f);
                mst += dl;
#pragma unroll
                for (int sb = 0; sb < 2; ++sb)
#pragma unroll
                    for (int i = 0; i < 16; ++i) s[sb][i] -= dl;
                if (!first) { const float f = __builtin_amdgcn_exp2f(-dl); lrun *= f;
#pragma unroll
                    for (int db = 0; db < VSUB; ++db) o[db] *= f; }
#pragma unroll
                for (int i = 0; i < 16; ++i) negm[i] = -mst;
            }
#pragma unroll
            for (int sb = 0; sb < 2; ++sb)
#pragma unroll
                for (int i = 0; i < 16; ++i) s[sb][i] = __builtin_amdgcn_exp2f(s[sb][i]);
            {
                f32x2 a2 = (f32x2){s[0][0], s[0][1]} + (f32x2){s[1][0], s[1][1]};
#pragma unroll
                for (int i = 2; i < 16; i += 2) { a2 += (f32x2){s[0][i], s[0][i + 1]}; a2 += (f32x2){s[1][i], s[1][i + 1]}; }
                lrun += a2[0] + a2[1];
            }
            bf16x8 pf[4];
#pragma unroll
            for (int st = 0; st < 4; ++st) { const int sb = st >> 1, b8 = (st & 1) * 8;
                u32x4 w; w[0] = pk2(s[sb][b8 + 0], s[sb][b8 + 1]); w[1] = pk2(s[sb][b8 + 2], s[sb][b8 + 3]); w[2] = pk2(s[sb][b8 + 4], s[sb][b8 + 5]); w[3] = pk2(s[sb][b8 + 6], s[sb][b8 + 7]);
                pf[st] = __builtin_bit_cast(bf16x8, w); }
            const LAS unsigned char* vp = lds + VB0 + buf * VBS + (4 * hi + ((lane & 15) >> 2)) * 64 + ((lane >> 4) & 1) * 32 + (lane & 3) * 8;
#pragma unroll
            for (int st = 0; st < 4; ++st)
#pragma unroll
                for (int db = 0; db < VSUB; ++db) {
                    const s16x4 lo = vtr(vp + ((2 * st) * VSUB + db) * 512), hh = vtr(vp + ((2 * st + 1) * VSUB + db) * 512);
                    const bf16x8 vf = __builtin_shufflevector(lo, hh, 0, 1, 2, 3, 4, 5, 6, 7);
                    o[db] = __builtin_amdgcn_mfma_f32_32x32x16_bf16(vf, pf[st], o[db], 0, 0, 0);
                }
        }
        if (buf == 0) { if (j + 1 < NT) ATT_STORE(1, sg1); if (j + 3 < NT) ATT_LOAD(NT - 4 - j, sg1); }
        else          { if (j + 1 < NT) ATT_STORE(0, sg0); if (j + 3 < NT) ATT_LOAD(NT - 4 - j, sg0); }
        ATT_BAR();
    }
    if (wact) {
        const float lt = lrun + __shfl_xor(lrun, 32), inv = 1.0f / lt;
        bf16_t* op = d.O + (size_t)(wid * 32 + r32) * d.ldo + 4 * hi;
#pragma unroll
        for (int db = 0; db < VSUB; ++db)
#pragma unroll
            for (int g = 0; g < 4; ++g) { const f32x4 v = (f32x4){o[db][4 * g], o[db][4 * g + 1], o[db][4 * g + 2], o[db][4 * g + 3]} * inv; *(u32x2*)(op + db * 32 + 8 * g) = pk4(v); }
    }
#undef ATT_LOAD
#undef ATT_STORE
#undef ATT_BAR
}

template <int DK, int DV, int MODE, int ORD>
__device__ __forceinline__ void attn_unit_pipe(const AttnUnit& d, LAS unsigned char* lds) {
    static_assert(MODE == 0 || MODE == 1, "pipelined attention: FoX or MLA");
    constexpr int KS = DK * 2 + 16;
    constexpr int VSUB = DV / 32;
    constexpr int KB0 = 0, KBS = 17408, VB0 = 34816, VBS = 16384, CKO = 67584;
    int tid_ = threadIdx.x; asm volatile("" : "+v"(tid_)); const int tid = tid_, lane = tid & 63, wid = __builtin_amdgcn_readfirstlane(tid >> 6), r32 = lane & 31, hi = lane >> 5;
    const bool wact = (wid * 32 < d.nrows);
    const int qpw = d.qpos0 + wid * 32;
    int tmax = (MODE == 0) ? ((qpw + 31) >> 6) : (qpw >> 6);
    if (!wact) tmax = -1;
    const int NT = d.NT, j0 = NT - 1 - tmax;
    bf16x8 qf[DK / 16];
    {
        const bf16_t* qp = d.Q + (size_t)((wact ? wid * 32 : 0) + r32) * d.ldq + hi * 8;
#pragma unroll
        for (int ks = 0; ks < DK / 16; ++ks) qf[ks] = *(const bf16x8*)(qp + ks * 16);
    }
    if (MODE == 1) {
        const int pos = (wact ? qpw : d.qpos0) + r32; const float* cp = d.ROPE + pos * 16 + hi * 8;
        const f32x4 c0 = *(const f32x4*)cp, c1 = *(const f32x4*)(cp + 4), s0 = *(const f32x4*)(cp + 65536), s1 = *(const f32x4*)(cp + 65540);
        const u32x4 a = __builtin_bit_cast(u32x4, qf[4]), b = __builtin_bit_cast(u32x4, qf[5]); u32x4 oa, ob;
#pragma unroll
        for (int k = 0; k < 4; ++k) {
            const float x1l = __uint_as_float(a[k] << 16), x1h = __uint_as_float(a[k] & 0xffff0000u), x2l = __uint_as_float(b[k] << 16), x2h = __uint_as_float(b[k] & 0xffff0000u);
            const float cl = (k < 2) ? c0[2 * k] : c1[2 * k - 4], ch = (k < 2) ? c0[2 * k + 1] : c1[2 * k - 3], sl = (k < 2) ? s0[2 * k] : s1[2 * k - 4], sh = (k < 2) ? s0[2 * k + 1] : s1[2 * k - 3];
            oa[k] = pk2(x1l * cl - x2l * sl, x1h * ch - x2h * sh); ob[k] = pk2(x2l * cl + x1l * sl, x2h * ch + x1h * sh);
        }
        qf[4] = __builtin_bit_cast(bf16x8, oa); qf[5] = __builtin_bit_cast(bf16x8, ob);
    }
    float cq = 0.f;
    if (MODE == 0) cq = d.CK[(size_t)((wact ? qpw : d.qpos0) + r32) * 8];
    struct StK { u32x4 k; u32x4 k2; float ck; };
    StK ka, kb; ka.k2 = (u32x4){0u, 0u, 0u, 0u}; kb.k2 = ka.k2; ka.ck = 0.f; kb.ck = 0.f;
    u32x4 va, vb;
    const int srow = tid >> 3, sc8 = tid & 7;
#define PL_LOADK(j, SG) do { const int t_ = NT - 1 - (j); \
        SG.k = *(const u32x4*)(d.K + (size_t)(t_ * 64 + srow) * d.ldk + sc8 * 8); \
        if (MODE == 1) { if (tid < 256) SG.k2 = *(const u32x4*)(d.K2 + (size_t)(t_ * 64 + (tid >> 2)) * 32 + (tid & 3) * 8); } \
        if (MODE == 0) { if (tid < 64) SG.ck = d.CK[(size_t)(t_ * 64 + tid) * 8]; } } while (0)
#define PL_LOADV(j, VR) do { const int t_ = NT - 1 - (j); VR = *(const u32x4*)(d.V + (size_t)(t_ * 64 + srow) * d.ldv + sc8 * 8); } while (0)
#define PL_STOREK(buf, SG) do { \
        *(LAS u32x4*)(lds + KB0 + (buf) * KBS + srow * KS + sc8 * 16) = SG.k; \
        if (MODE == 1) { if (tid < 256) *(LAS u32x4*)(lds + KB0 + (buf) * KBS + (tid >> 2) * KS + 128 + (tid & 3) * 16) = SG.k2; } \
        if (MODE == 0) { if (tid < 64) *(LAS float*)(lds + CKO + (buf) * 256 + tid * 4) = SG.ck; } } while (0)
#define PL_STOREV(buf, VR) do { *(LAS u32x4*)(lds + VB0 + (buf) * VBS + ((srow >> 3) * VSUB + (sc8 >> 2)) * 512 + (srow & 7) * 64 + (sc8 & 3) * 16) = VR; } while (0)
#define PL_BAR() do { asm volatile("s_waitcnt lgkmcnt(0)" ::: "memory"); __builtin_amdgcn_s_barrier(); asm volatile("" ::: "memory"); } while (0)
    f32x16 o[VSUB], negm;
#pragma unroll
    for (int db = 0; db < VSUB; ++db)
#pragma unroll
        for (int i = 0; i < 16; ++i) o[db][i] = 0.f;
#pragma unroll
    for (int i = 0; i < 16; ++i) negm[i] = 0.f;
    float mst = 0.f, lrun = 0.f;
    constexpr float THR = 8.0f;
#define PL_QK(S, kb_) do { \
        if (MODE == 0) { const float base_ = cq - mst; \
            _Pragma("unroll") for (int sb = 0; sb < 2; ++sb) _Pragma("unroll") for (int g = 0; g < 4; ++g) { \
                const f32x4 ck_ = *(const LAS f32x4*)(lds + CKO + (kb_) * 256 + (sb * 32 + 8 * g + 4 * hi) * 4); \
                _Pragma("unroll") for (int e = 0; e < 4; ++e) S[sb][4 * g + e] = base_ - ck_[e]; } } \
        else { S[0] = negm; S[1] = negm; } \
        const LAS unsigned char* kp_ = lds + KB0 + (kb_) * KBS + r32 * KS + hi * 16; \
        _Pragma("unroll") for (int ks = 0; ks < DK / 16; ++ks) { \
            const bf16x8 a0_ = *(const LAS bf16x8*)(kp_ + ks * 32), a1_ = *(const LAS bf16x8*)(kp_ + 32 * KS + ks * 32); \
            S[0] = __builtin_amdgcn_mfma_f32_32x32x16_bf16(a0_, qf[ks], S[0], 0, 0, 0); \
            S[1] = __builtin_amdgcn_mfma_f32_32x32x16_bf16(a1_, qf[ks], S[1], 0, 0, 0); } } while (0)
#define PL_SOFT_PV(j, PAR, SC, SN, FIXN) do { \
            const bool first_ = ((j) == j0); const int t_ = NT - 1 - (j); \
            if (MODE == 0) { if (t_ * 64 + 63 > qpw) { const int qp_ = qpw + r32; \
                _Pragma("unroll") for (int sb = 0; sb < 2; ++sb) _Pragma("unroll") for (int i = 0; i < 16; ++i) { const int kvp_ = t_ * 64 + sb * 32 + crow(i, hi); if (kvp_ > qp_) SC[sb][i] = -1e30f; } } } \
            float rm_ = fmaxf(fmaxf(SC[0][0], SC[0][1]), SC[0][2]); \
            _Pragma("unroll") for (int i = 3; i < 15; i += 2) rm_ = fmaxf(fmaxf(rm_, SC[0][i]), SC[0][i + 1]); \
            rm_ = fmaxf(fmaxf(rm_, SC[0][15]), SC[1][0]); \
            _Pragma("unroll") for (int i = 1; i < 15; i += 2) rm_ = fmaxf(fmaxf(rm_, SC[1][i]), SC[1][i + 1]); \
            rm_ = fmaxf(rm_, SC[1][15]); \
            { auto rr_ = __builtin_amdgcn_permlane32_swap(__float_as_uint(rm_), __float_as_uint(rm_), false, false); rm_ = fmaxf(__uint_as_float(rr_[0]), __uint_as_float(rr_[1])); } \
            if (first_ || __any(rm_ > THR)) { \
                const float dl_ = first_ ? rm_ : fmaxf(rm_, 0.f); mst += dl_; \
                _Pragma("unroll") for (int sb = 0; sb < 2; ++sb) _Pragma("unroll") for (int i = 0; i < 16; ++i) SC[sb][i] -= dl_; \
                if (FIXN) { _Pragma("unroll") for (int sb = 0; sb < 2; ++sb) _Pragma("unroll") for (int i = 0; i < 16; ++i) SN[sb][i] -= dl_; } \
                if (!first_) { const float f_ = __builtin_amdgcn_exp2f(-dl_); lrun *= f_; _Pragma("unroll") for (int db = 0; db < VSUB; ++db) o[db] *= f_; } \
                _Pragma("unroll") for (int i = 0; i < 16; ++i) negm[i] = -mst; } \
            _Pragma("unroll") for (int sb = 0; sb < 2; ++sb) _Pragma("unroll") for (int i = 0; i < 16; ++i) SC[sb][i] = __builtin_amdgcn_exp2f(SC[sb][i]); \
            { float a0_ = SC[0][0] + SC[1][0], a1_ = SC[0][1] + SC[1][1]; \
              _Pragma("unroll") for (int i = 2; i < 16; i += 2) { a0_ += SC[0][i]; a1_ += SC[0][i + 1]; a0_ += SC[1][i]; a1_ += SC[1][i + 1]; } \
              lrun += a0_ + a1_; } \
            bf16x8 pf_[4]; \
            _Pragma("unroll") for (int st = 0; st < 4; ++st) { const int sb = st >> 1, b8 = (st & 1) * 8; u32x4 w_; \
                w_[0] = pk2(SC[sb][b8 + 0], SC[sb][b8 + 1]); w_[1] = pk2(SC[sb][b8 + 2], SC[sb][b8 + 3]); w_[2] = pk2(SC[sb][b8 + 4], SC[sb][b8 + 5]); w_[3] = pk2(SC[sb][b8 + 6], SC[sb][b8 + 7]); \
                pf_[st] = __builtin_bit_cast(bf16x8, w_); } \
            const LAS unsigned char* vp_ = lds + VB0 + (PAR) * VBS + (4 * hi + ((lane & 15) >> 2)) * 64 + ((lane >> 4) & 1) * 32 + (lane & 3) * 8; \
            _Pragma("unroll") for (int st = 0; st < 4; ++st) _Pragma("unroll") for (int db = 0; db < VSUB; ++db) { \
                const s16x4 lo_ = vtr(vp_ + ((2 * st) * VSUB + db) * 512), hh_ = vtr(vp_ + ((2 * st + 1) * VSUB + db) * 512); \
                const bf16x8 vf_ = __builtin_shufflevector(lo_, hh_, 0, 1, 2, 3, 4, 5, 6, 7); \
                o[db] = __builtin_amdgcn_mfma_f32_32x32x16_bf16(vf_, pf_[st], o[db], 0, 0, 0); } } while (0)
#define PL_STEP(j, PAR, SC, SN, KSG, VR) do { \
        const bool has_nxt_ = ((j) + 1 < NT) && ((j) + 1 >= j0); \
        if (ORD == 0) { \
            if (has_nxt_) PL_QK(SN, (PAR) ^ 1); \
            if ((j) >= j0) PL_SOFT_PV(j, PAR, SC, SN, has_nxt_); \
        } else { \
            if ((j) >= j0) PL_SOFT_PV(j, PAR, SC, SN, false); \
            if (has_nxt_) PL_QK(SN, (PAR) ^ 1); \
        } \
        if ((j) + 2 < NT) PL_STOREK(PAR, KSG); \
        if ((j) + 1 < NT) PL_STOREV((PAR) ^ 1, VR); \
        if ((j) + 4 < NT) PL_LOADK((j) + 4, KSG); \
        if ((j) + 3 < NT) PL_LOADV((j) + 3, VR); \
        PL_BAR(); } while (0)
    PL_LOADK(0, ka); PL_LOADV(0, va); if (NT > 1) PL_LOADK(1, kb);
    PL_STOREK(0, ka); PL_STOREV(0, va); if (NT > 1) PL_STOREK(1, kb);
    if (NT > 2) PL_LOADK(2, ka); if (NT > 3) PL_LOADK(3, kb); if (NT > 1) PL_LOADV(1, vb); if (NT > 2) PL_LOADV(2, va);
    PL_BAR();
    f32x16 sa[2], sb2[2];
#pragma unroll
    for (int i = 0; i < 16; ++i) { sa[0][i] = 0.f; sa[1][i] = 0.f; sb2[0][i] = 0.f; sb2[1][i] = 0.f; }
    if (0 >= j0) PL_QK(sa, 0);
    PL_BAR();
    for (int j = 0; j < NT; j += 2) {
        PL_STEP(j, 0, sa, sb2, ka, vb);
        if (j + 1 < NT) PL_STEP(j + 1, 1, sb2, sa, kb, va);
    }
    if (wact) {
        const float lt = lrun + __shfl_xor(lrun, 32), inv = 1.0f / lt;
        bf16_t* op = d.O + (size_t)(wid * 32 + r32) * d.ldo + 4 * hi;
#pragma unroll
        for (int db = 0; db < VSUB; ++db)
#pragma unroll
            for (int g = 0; g < 4; ++g) { const f32x4 v = (f32x4){o[db][4 * g], o[db][4 * g + 1], o[db][4 * g + 2], o[db][4 * g + 3]} * inv; *(u32x2*)(op + db * 32 + 8 * g) = pk4(v); }
    }
#undef PL_LOADK
#undef PL_LOADV
#undef PL_STOREK
#undef PL_STOREV
#undef PL_BAR
#undef PL_QK
#undef PL_SOFT_PV
#undef PL_STEP
}

__device__ __forceinline__ void transpose_item(const float* __restrict__ W, int ldw, int srccol0, int nvalid, const float* __restrict__ gk,
                                               bf16_t* WT, int K, int dstrow0, int k0, LAS float* scr, int lane) {
#pragma unroll
    for (int i = 0; i < 32; ++i) { const int kk = 2 * i + (lane >> 5), n = lane & 31; float v = 0.f;
        if (n < nvalid) { v = W[(size_t)(k0 + kk) * ldw + srccol0 + n]; if (gk) v *= gk[k0 + kk]; }
        scr[kk * 33 + n] = v; }
    LDS_WAIT();
    const int c = lane & 7;
#pragma unroll
    for (int j = 0; j < 4; ++j) { const int n = (lane >> 3) + 8 * j; const LAS float* s = scr + (8 * c) * 33 + n;
        u32x4 o; o.x = pk2(s[0 * 33], s[1 * 33]); o.y = pk2(s[2 * 33], s[3 * 33]); o.z = pk2(s[4 * 33], s[5 * 33]); o.w = pk2(s[6 * 33], s[7 * 33]);
        *(u32x4*)(WT + (size_t)(dstrow0 + n) * K + k0 + 8 * c) = o; }
    LDS_WAIT();
}
__device__ __forceinline__ void rms_rows4_to_bf16(const float* xrow, const float* g, bf16_t* orow, int lane) {
    f32x4 v[16]; float s[4];
#pragma unroll
    for (int j = 0; j < 16; ++j) v[j] = ((const f32x4*)xrow)[lane + 64 * j];
#pragma unroll
    for (int k = 0; k < 4; ++k) { s[k] = (dot4(v[4 * k]) + dot4(v[4 * k + 1])) + (dot4(v[4 * k + 2]) + dot4(v[4 * k + 3])); }
#pragma unroll
    for (int k = 0; k < 4; ++k) s[k] = rsqrtf(wave_sum(s[k]) * (1.0f / 1024.0f) + EPS);
#pragma unroll
    for (int j = 0; j < 16; ++j) { const f32x4 gg = ((const f32x4*)g)[lane + 64 * (j & 3)]; ((u32x2*)orow)[lane + 64 * j] = pk4(v[j] * s[j >> 2] * gg); }
}
template <int W8, int RPG>
__device__ __forceinline__ void cvt_rows(const float* src, bf16_t* dst, int nrows, int drow0, int dstride, unsigned gtid, unsigned gthreads) {
    const unsigned total = (unsigned)nrows * W8;
    for (unsigned idx = gtid; idx < total; idx += 2 * gthreads) {
        const unsigned idx2 = idx + gthreads; const bool two = idx2 < total;
        const f32x4 a = *(const f32x4*)(src + (size_t)idx * 8), b = *(const f32x4*)(src + (size_t)idx * 8 + 4);
        f32x4 c = a, e = b; if (two) { c = *(const f32x4*)(src + (size_t)idx2 * 8); e = *(const f32x4*)(src + (size_t)idx2 * 8 + 4); }
        { const unsigned row = idx / W8, c8 = idx % W8, drow = drow0 + (row / RPG) * dstride + (row % RPG);
          *(u32x4*)(dst + ((size_t)drow * W8 + c8) * 8) = (u32x4){pk2(a[0], a[1]), pk2(a[2], a[3]), pk2(b[0], b[1]), pk2(b[2], b[3])}; }
        if (two) { const unsigned row = idx2 / W8, c8 = idx2 % W8, drow = drow0 + (row / RPG) * dstride + (row % RPG);
          *(u32x4*)(dst + ((size_t)drow * W8 + c8) * 8) = (u32x4){pk2(c[0], c[1]), pk2(c[2], c[3]), pk2(e[0], e[1]), pk2(e[2], e[3])}; }
    }
}

#define XB_TMO      128
#define XB_XCNT(j)  (256  + 64 * (j))
#define XB_XSUB(j)  (1280 + 64 * (j))
#define XB_XGEN(j)  (2304 + 64 * (j))
#define XB_TOP      3328
#define XB_TOPGEN   3392
#define XCD_BAR_WORDS 3456
#define XB_SPIN_CAP (1u << 18)

__device__ __forceinline__ unsigned xb_ld(unsigned* p)              { return __hip_atomic_load(p, __ATOMIC_RELAXED, __HIP_MEMORY_SCOPE_AGENT); }
__device__ __forceinline__ unsigned xb_add(unsigned* p, unsigned v) { return __hip_atomic_fetch_add(p, v, __ATOMIC_RELAXED, __HIP_MEMORY_SCOPE_AGENT); }
__device__ __forceinline__ unsigned xb_xcc_id() { return (unsigned)__builtin_amdgcn_s_getreg((3 << 11) | 20) & 0xFu; }
#define XB_SPIN(cond, bar) do { unsigned _sp = 0; while (cond) { __builtin_amdgcn_s_sleep(1); \
    if ((++_sp & 255u) == 0u) { if (xb_ld(&(bar)[XB_TMO])) break; if (_sp > XB_SPIN_CAP) { atomicAdd(&(bar)[XB_TMO], 1u); break; } } } } while (0)

struct XcdBarrier {
    unsigned* bar; unsigned x;
    volatile LAS unsigned* st;
};

__device__ __forceinline__ XcdBarrier xcd_barrier_post(unsigned* bar, volatile LAS unsigned* st) {
    XcdBarrier b; b.bar = bar; b.x = xb_xcc_id(); b.st = st;
    if (threadIdx.x == 0) (void)xb_add(&bar[XB_XCNT(b.x)], 1u);
    return b;
}
__device__ __forceinline__ void xcd_barrier_complete(unsigned* bar, unsigned x, unsigned& nloc, unsigned& nx) {
    const unsigned G = gridDim.x * gridDim.y * gridDim.z;
    unsigned sum, cnt, mine, sp = 0u;
    for (;;) {
        sum = 0u; cnt = 0u; mine = 0u;
#pragma unroll
        for (unsigned j = 0; j < 16; ++j) { const unsigned c = xb_ld(&bar[XB_XCNT(j)]); sum += c; cnt += (c > 0u) ? 1u : 0u; mine = (j == x) ? c : mine; }
        if (sum == G) break;
        __builtin_amdgcn_s_sleep(1);
        if ((++sp & 255u) == 0u) { if (xb_ld(&bar[XB_TMO])) break; if (sp > XB_SPIN_CAP) { atomicAdd(&bar[XB_TMO], 1u); break; } }
    }
    nloc = mine > 0u ? mine : 1u; nx = cnt > 0u ? cnt : 1u;
}

__device__ __forceinline__ void xcd_barrier(const XcdBarrier& b) {
    asm volatile("s_waitcnt vmcnt(0)" ::: "memory");
    __syncthreads();
    if (threadIdx.x == 0) {
        unsigned* bar = b.bar;
        __builtin_amdgcn_s_waitcnt(0);
        unsigned nloc = b.st[0], nx = b.st[1];
        if (nloc == 0u) { xcd_barrier_complete(bar, b.x, nloc, nx); b.st[0] = nloc; b.st[1] = nx; }
        const unsigned old = xb_add(&bar[XB_XSUB(b.x)], 1u);
        const unsigned gen = old / nloc;
        if (old + 1u == (gen + 1u) * nloc) {
            __builtin_amdgcn_fence(__ATOMIC_RELEASE, "agent");
            asm volatile("s_waitcnt vmcnt(0)" ::: "memory");
            const unsigned og = xb_add(&bar[XB_TOP], 1u);
            const unsigned tg = og / nx;
            if (og + 1u == (tg + 1u) * nx) xb_add(&bar[XB_TOPGEN], 1u);
            else XB_SPIN(xb_ld(&bar[XB_TOPGEN]) == tg, bar);
            __builtin_amdgcn_fence(__ATOMIC_ACQUIRE, "agent");
            xb_add(&bar[XB_XGEN(b.x)], 1u);
            asm volatile("s_waitcnt vmcnt(0)" ::: "memory");
        } else {
            XB_SPIN(xb_ld(&bar[XB_XGEN(b.x)]) == gen, bar);
            __builtin_amdgcn_fence(__ATOMIC_ACQUIRE, "agent");
            asm volatile("s_waitcnt vmcnt(0)" ::: "memory");
        }
    }
    __syncthreads();
}

constexpr int LDS_BYTES = 135168;
__global__ void __launch_bounds__(NTHR, 2) fwd_kernel(Params P) {
    extern __shared__ __attribute__((aligned(16))) unsigned char lds_raw[];
    LAS unsigned char* lds = (LAS unsigned char*)lds_raw;
    cg::grid_group grid = cg::this_grid();
    if (threadIdx.x < 64) ((LAS unsigned*)(lds + 131072))[threadIdx.x] = 0u;
    __syncthreads();
    XcdBarrier xbar = xcd_barrier_post((unsigned*)(P.ws + WS_CTL), (volatile LAS unsigned*)(lds + 131072) + 8);
    const int wid = __builtin_amdgcn_readfirstlane(threadIdx.x >> 6);
    const int G = gridDim.x, bx = blockIdx.x;
#define FRESH_TID() int tid_ = threadIdx.x; asm volatile("" : "+v"(tid_)); const int tid = tid_, lane = tid & 63; (void)lane; const size_t gtid = (size_t)bx * NTHR + tid; (void)gtid
    const int vcu = (G % 8 == 0) ? (bx % 8) * (G / 8) + bx / 8 : bx;
    const int gw = bx * 8 + wid, NGW = G * 8;
    const size_t gthreads = (size_t)G * NTHR;
    unsigned char* ws = P.ws; float* out = P.out;
    bf16_t *W_IN = (bf16_t*)(ws + WS_W_IN), *W_UQ = (bf16_t*)(ws + WS_W_UQ), *W_UKV = (bf16_t*)(ws + WS_W_UKV), *W_O = (bf16_t*)(ws + WS_W_O), *W_MKV = (bf16_t*)(ws + WS_W_MKV),
           *W_MQ = (bf16_t*)(ws + WS_W_MQ), *W_MO = (bf16_t*)(ws + WS_W_MO), *W_GU = (bf16_t*)(ws + WS_W_GU), *W_D = (bf16_t*)(ws + WS_W_D);
    float *COS = (float*)(ws + WS_ROPE), *SIN = COS + 4096 * 16;
    float *SSQQ = (float*)(ws + WS_SSQ), *SSQ1 = SSQQ + MT, *SSQ2 = SSQ1 + MT, *SSQ3 = SSQ2 + MT;
    float* CUM = (float*)(ws + WS_CUM);
    bf16_t *MEMK = (bf16_t*)(ws + WS_MEMK), *MEMV = (bf16_t*)(ws + WS_MEMV), *MN = (bf16_t*)(ws + WS_MN), *XN = (bf16_t*)(ws + WS_XN), *ATT = XN;
    float* ZS = (float*)(ws + WS_ZS);
    bf16_t *QF = (bf16_t*)(ws + WS_QF), *KF = (bf16_t*)(ws + WS_KF), *VF = (bf16_t*)(ws + WS_VF), *CQR = (bf16_t*)(ws + WS_CQR), *CKVB = (bf16_t*)(ws + WS_CKVB), *KRB = (bf16_t*)(ws + WS_KRB),
           *MQ = (bf16_t*)(ws + WS_MQ), *MKN = (bf16_t*)(ws + WS_MKN), *MV = (bf16_t*)(ws + WS_MV);
    bf16_t *XB = (bf16_t*)(ws + WS_XB), *CQ = (bf16_t*)(ws + WS_CQ), *CO = (bf16_t*)(ws + WS_CO), *HB = (bf16_t*)(ws + WS_H);
    const int lo = P.ph_lo, hi_ph = P.ph_hi;
#ifndef PHASE_MASK
#define PHASE_MASK 0x1fff
#endif
#define IN(k) (((PHASE_MASK >> (k)) & 1) && lo <= (k) && (k) < hi_ph)
#define SEAM(k) do { if (IN(k) && IN((k) + 1)) { if (P.ph_lo < 0) grid.sync(); else xcd_barrier(xbar); } } while (0)

    if (IN(0)) {
        FRESH_TID();
        for (size_t i = gtid; i < (size_t)4 * MT; i += gthreads) SSQQ[i] = 0.f;
        for (size_t i = gtid; i < (size_t)4096 * 16; i += gthreads) {
            const int pos = (int)(i >> 4), j = (int)(i & 15); const double a = (double)pos * ROPE_INV[j] * 0.15915494309189535; const float fr_ = (float)(a - floor(a));
            COS[i] = __builtin_amdgcn_cosf(fr_); SIN[i] = __builtin_amdgcn_sinf(fr_);
        }
        {
            LAS float* scr = (LAS float*)(lds + wid * 16384);
            constexpr int I1 = 16 * 72, I2 = 6 * 24, I3 = 4 * 32, I4 = 16 * 32, I5 = 16 * 32, I6 = 16 * 16, I7 = 8 * 32, I8 = 16 * 176, I9 = 44 * 32;
            constexpr int NIT = I1 + I2 + I3 + I4 + I5 + I6 + I7 + I8 + I9;
            for (int it = gw; it < NIT; it += NGW) {
                int r = it;
                if (r < I1) { const int kb = r / 72, nb = r % 72, n0 = nb * 32; int src, nv;
                    if (n0 < 1536) { src = n0; nv = 32; } else if (n0 < 2208) { src = n0 + 8; nv = 32; } else if (n0 == 2208) { src = 1536; nv = 8; } else { src = 0; nv = 0; }
                    transpose_item(P.in[11], 2216, src, nv, nullptr, W_IN, 1024, n0, kb * 64, scr, lane); continue; } r -= I1;
                if (r < I2) { const int kb = r / 24, nb = r % 24; transpose_item(P.in[14], 768, nb * 32, 32, P.in[13], W_UQ, 384, nb * 32, kb * 64, scr, lane); continue; } r -= I2;
                if (r < I3) { const int kb = r / 32, nb = r % 32; transpose_item(P.in[16], 1024, nb * 32, 32, nullptr, W_UKV, 256, nb * 32, kb * 64, scr, lane); continue; } r -= I3;
                if (r < I4) { const int kb = r / 32, nb = r % 32; transpose_item(P.in[19], 1024, nb * 32, 32, nullptr, W_O, 1024, nb * 32, kb * 64, scr, lane); continue; } r -= I4;
                if (r < I5) { const int kb = r / 32, nb = r % 32; transpose_item(nb < 16 ? P.in[21] : P.in[22], 512, (nb & 15) * 32, 32, nullptr, W_MKV, 1024, nb * 32, kb * 64, scr, lane); continue; } r -= I5;
                if (r < I6) { const int kb = r / 16, nb = r % 16; transpose_item(P.in[24], 512, nb * 32, 32, P.in[23], W_MQ, 1024, nb * 32, kb * 64, scr, lane); continue; } r -= I6;
                if (r < I7) { const int kb = r / 32, nb = r % 32; transpose_item(P.in[25], 1024, nb * 32, 32, nullptr, W_MO, 512, nb * 32, kb * 64, scr, lane); continue; } r -= I7;
                if (r < I8) { const int kb = r / 176, nb = r % 176, tile = nb >> 3, j = nb & 7;
                    transpose_item(j < 4 ? P.in[27] : P.in[28], 2816, tile * 128 + (j & 3) * 32, 32, P.in[26], W_GU, 1024, nb * 32, kb * 64, scr, lane); continue; } r -= I8;
                { const int kb = r / 32, nb = r % 32; transpose_item(P.in[29], 1024, nb * 32, 32, nullptr, W_D, 2816, nb * 32, kb * 64, scr, lane); }
            }
        }
        for (int m = gw * 4; m < MT; m += NGW * 4) rms_rows4_to_bf16(m < MP ? P.in[0] + (size_t)m * 1024 : P.in[1] + (size_t)(m - MP) * 1024, P.in[10], XN + (size_t)m * 1024, lane);
        for (int m = gw * 4; m < 4096; m += NGW * 4) rms_rows4_to_bf16(P.in[2] + (size_t)m * 1024, P.in[20], MN + (size_t)m * 1024, lane);
        cvt_rows<64, 2048>(P.in[3], KF, 16384, MP, SKV, (unsigned)gtid, (unsigned)gthreads);
        cvt_rows<64, 2048>(P.in[4], VF, 16384, MP, SKV, (unsigned)gtid, (unsigned)gthreads);
        cvt_rows<32, 2048>(P.in[6], CKVB, 16384, MP, SKV, (unsigned)gtid, (unsigned)gthreads);
        cvt_rows<4, 2048>(P.in[7], KRB, 16384, MP, SKV, (unsigned)gtid, (unsigned)gthreads);
        cvt_rows<64, 2048>(P.in[8], MEMK, 2048, 4096, 0, (unsigned)gtid, (unsigned)gthreads);
        cvt_rows<64, 2048>(P.in[9], MEMV, 2048, 4096, 0, (unsigned)gtid, (unsigned)gthreads);
    }
    SEAM(0);
    if (IN(1)) {
        { pg8::Gemm g{XN, W_IN, MT, 2304, 1024}; pg8::StaticOrder S; S.init(MT, 2304, G, bx); Epi1 E{QF, KF, VF, CQR, ZS, SSQQ, out};
          pg8::gemm_phase<Epi1, pg8::StaticOrder, true, true>(lds, g, S, E); }
        { pg8::Gemm g{MN, W_MKV, 4096, 1024, 1024}; pg8::StaticOrder S; S.init(4096, 1024, G, (bx + 64) % G); EpiM E{MEMK, MEMV, out};
          pg8::gemm_phase<EpiM, pg8::StaticOrder, true, true>(lds, g, S, E); }
    }
    SEAM(1);
    if (IN(2)) {
        FRESH_TID();
        for (int r0 = gw * 4; r0 < MT; r0 += NGW * 4) {
            f32x4 v[4]; float x1[4], x2[4], fz[4];
#pragma unroll
            for (int k = 0; k < 4; ++k) { const float* z = ZS + (size_t)(r0 + k) * 384; v[k] = *(const f32x4*)(z + 4 * lane); x1[k] = 0.f; x2[k] = 0.f; fz[k] = 0.f;
                if (lane < 16) { x1[k] = z[256 + lane]; x2[k] = z[272 + lane]; } if (lane < 8) fz[k] = z[288 + lane]; }
            const f32x4 gkv = *(const f32x4*)(P.in[15] + 4 * lane); const float bf = (lane < 8) ? P.in[12][lane] : 0.f;
            float rs[4];
#pragma unroll
            for (int k = 0; k < 4; ++k) rs[k] = dot4(v[k]);
#pragma unroll
            for (int k = 0; k < 4; ++k) rs[k] = rsqrtf(wave_sum(rs[k]) * (1.0f / 256.0f) + EPS);
#pragma unroll
            for (int k = 0; k < 4; ++k) { const int r = r0 + k; const bool samp = r >= MP; const int orow = samp ? r - MP : r, kr = kvrow(r);
                const f32x4 ov = v[k] * rs[k] * gkv;
                *(f32x4*)(out + (samp ? OFF_S_CKV : OFF_P_CKV) + (size_t)orow * 256 + 4 * lane) = ov;
                *(u32x2*)(CKVB + (size_t)kr * 256 + 4 * lane) = pk4(ov);
                if (lane < 16) { const int pos = rowpos(r); const float c = COS[pos * 16 + lane], sn = SIN[pos * 16 + lane];
                    const float o1 = x1[k] * c - x2[k] * sn, o2 = x2[k] * c + x1[k] * sn; float* po = out + (samp ? OFF_S_KR : OFF_P_KR) + (size_t)orow * 32;
                    po[lane] = o1; po[lane + 16] = o2; bf16_t* pb = KRB + (size_t)kr * 32; pb[lane] = (bf16_t)(pk2(o1, 0.f) & 0xffffu); pb[lane + 16] = (bf16_t)(pk2(o2, 0.f) & 0xffffu); }
                if (lane < 8) { const float f = fz[k] + bf; const float lf = fminf(f, 0.f) - log1pf(__expf(-fabsf(f)));
                    out[(samp ? OFF_S_LOGF : OFF_P_LOGF) + (size_t)orow * 8 + lane] = lf; } }
        }
    }
    SEAM(2);
    if (IN(3)) {
        FRESH_TID();
        for (int job = bx; job < 24; job += G) {
            LAS float* TS = (LAS float*)lds; const bool samp = job >= 16; const int sb = job - 16, nthr = samp ? 264 : 512;
            const float* src; if (!samp) src = out + OFF_P_LOGF + ((size_t)job * 4096 + tid * 8) * 8; else if (tid < 256) src = P.in[5] + ((size_t)sb * 2048 + tid * 8) * 8; else src = out + OFF_S_LOGF + ((size_t)sb * 64 + (tid - 256) * 8) * 8;
            float s[8];
#pragma unroll
            for (int k = 0; k < 8; ++k) s[k] = 0.f;
            if (tid < nthr) {
#pragma unroll
                for (int r = 0; r < 8; ++r) { const f32x4 a = *(const f32x4*)(src + r * 8), b = *(const f32x4*)(src + r * 8 + 4);
                    s[0] += a[0]; s[1] += a[1]; s[2] += a[2]; s[3] += a[3]; s[4] += b[0]; s[5] += b[1]; s[6] += b[2]; s[7] += b[3]; }
            }
#pragma unroll
            for (int k = 0; k < 8; ++k) TS[tid * 8 + k] = s[k];
            __syncthreads();
            { float part = 0.f, loc[8];
#pragma unroll
                for (int k = 0; k < 8; ++k) { loc[k] = part; part += TS[(lane * 8 + k) * 8 + wid]; }
                float inc = part;
#pragma unroll
                for (int o = 1; o < 64; o <<= 1) { const float t = __shfl_up(inc, o); if (lane >= o) inc += t; }
                const float exc = inc - part;
#pragma unroll
                for (int k = 0; k < 8; ++k) TS[(lane * 8 + k) * 8 + wid] = exc + loc[k]; }
            __syncthreads();
            if (tid < nthr) {
#pragma unroll
                for (int k = 0; k < 8; ++k) s[k] = TS[tid * 8 + k];
                float* dst = CUM + ((size_t)(samp ? MP + sb * SKV : job * 4096) + tid * 8) * 8;
#pragma unroll
                for (int r = 0; r < 8; ++r) { const f32x4 a = *(const f32x4*)(src + r * 8), b = *(const f32x4*)(src + r * 8 + 4);
                    s[0] += a[0]; s[1] += a[1]; s[2] += a[2]; s[3] += a[3]; s[4] += b[0]; s[5] += b[1]; s[6] += b[2]; s[7] += b[3];
                    *(f32x4*)(dst + r * 8) = (f32x4){s[0], s[1], s[2], s[3]} * LOG2E; *(f32x4*)(dst + r * 8 + 4) = (f32x4){s[4], s[5], s[6], s[7]} * LOG2E; }
            }
            __syncthreads();
        }
        { pg8::Gemm g{CQR, W_UQ, MT, 768, 384}; pg8::StaticOrder S; S.init(MT, 768, G, bx); EpiScale E{MQ, 768, SSQQ, 1.0f / 384.0f, QS_MLA};
          pg8::gemm_phase<EpiScale, pg8::StaticOrder, true, true>(lds, g, S, E); }
        { pg8::Gemm g{CKVB, W_UKV, KVR, 1024, 256}; pg8::StaticOrder S; S.init(KVR, 1024, G, bx); Epi3 E{MKN, MV};
          pg8::gemm_phase<Epi3, pg8::StaticOrder, true, true>(lds, g, S, E); }
    }
    SEAM(3);
    if (IN(4)) {
        for (int uu = vcu; uu < 4224; uu += G) {
            AttnUnit d; bool mla; d.ROPE = COS;
            if (uu < 4096) {
                mla = uu >= 2048; const int u2 = uu & 2047, i = u2 >> 8, c = u2 & 255, bh = c >> 1, b = bh >> 3, h = bh & 7, qb = 2 * i + ((i & 1) ^ (c & 1));
                const size_t seq0 = (size_t)b * 4096, q0 = seq0 + qb * 256;
                d.nrows = 256; d.qpos0 = qb * 256; d.NT = (qb + 1) * 4;
                if (!mla) { d.Q = QF + q0 * 512 + h * 64; d.ldq = 512; d.K = KF + seq0 * 512 + h * 64; d.ldk = 512; d.K2 = nullptr; d.V = VF + seq0 * 512 + h * 64; d.ldv = 512; d.CK = CUM + seq0 * 8 + h; d.O = ATT + q0 * 1024 + h * 64; d.ldo = 1024; }
                else { d.Q = MQ + q0 * 768 + h * 96; d.ldq = 768; d.K = MKN + seq0 * 512 + h * 64; d.ldk = 512; d.K2 = KRB + seq0 * 32; d.V = MV + seq0 * 512 + h * 64; d.ldv = 512; d.CK = nullptr; d.O = ATT + q0 * 1024 + 512 + h * 64; d.ldo = 1024; }
            } else {
                const int u2 = uu - 4096; mla = u2 >= 64; const int sb = (u2 & 63) >> 3, h = u2 & 7;
                const size_t seq0 = (size_t)MP + (size_t)sb * SKV, q0 = (size_t)MP + sb * 64;
                d.nrows = 64; d.qpos0 = PAST; d.NT = 33;
                if (!mla) { d.Q = QF + q0 * 512 + h * 64; d.ldq = 512; d.K = KF + seq0 * 512 + h * 64; d.ldk = 512; d.K2 = nullptr; d.V = VF + seq0 * 512 + h * 64; d.ldv = 512; d.CK = CUM + seq0 * 8 + h; d.O = ATT + q0 * 1024 + h * 64; d.ldo = 1024; }
                else { d.Q = MQ + q0 * 768 + h * 96; d.ldq = 768; d.K = MKN + seq0 * 512 + h * 64; d.ldk = 512; d.K2 = KRB + seq0 * 32; d.V = MV + seq0 * 512 + h * 64; d.ldv = 512; d.CK = nullptr; d.O = ATT + q0 * 1024 + 512 + h * 64; d.ldo = 1024; }
            }
            if (wid < 4) { if (!mla) attn_unit_pipe<64, 64, 0, 0>(d, lds); else attn_unit_pipe<96, 64, 1, 0>(d, lds); }
            else         { if (!mla) attn_unit_pipe<64, 64, 0, 1>(d, lds); else attn_unit_pipe<96, 64, 1, 1>(d, lds); }
        }
    }
    SEAM(4);
    if (IN(5)) {
        FRESH_TID();
        for (int r0 = gw * 4; r0 < MT; r0 += NGW * 4) {
            bf16_t* a = ATT + (size_t)r0 * 1024; u32x4 w[8];
#pragma unroll
            for (int q = 0; q < 8; ++q) w[q] = *(const u32x4*)(a + (q >> 1) * 1024 + (q & 1) * 512 + lane * 8);
            float ss[8];
#pragma unroll
            for (int q = 0; q < 8; ++q) { float t = 0.f;
#pragma unroll
                for (int k = 0; k < 4; ++k) { const float xl = __uint_as_float(w[q][k] << 16), xh = __uint_as_float(w[q][k] & 0xffff0000u); t += xl * xl + xh * xh; }
                ss[q] = t; }
#pragma unroll
            for (int q = 0; q < 8; ++q) ss[q] = rsqrtf(wave_sum(ss[q]) * (1.0f / 512.0f) + EPS);
#pragma unroll
            for (int q = 0; q < 8; ++q) { const float* g = P.in[17 + (q & 1)] + lane * 8; const f32x4 g0 = *(const f32x4*)g, g1 = *(const f32x4*)(g + 4); const float rstd = ss[q]; float x[8];
#pragma unroll
                for (int k = 0; k < 4; ++k) { x[2 * k] = __uint_as_float(w[q][k] << 16); x[2 * k + 1] = __uint_as_float(w[q][k] & 0xffff0000u); }
                *(u32x4*)(a + (q >> 1) * 1024 + (q & 1) * 512 + lane * 8) = (u32x4){pk2(x[0] * rstd * g0[0], x[1] * rstd * g0[1]), pk2(x[2] * rstd * g0[2], x[3] * rstd * g0[3]),
                                                                                    pk2(x[4] * rstd * g1[0], x[5] * rstd * g1[1]), pk2(x[6] * rstd * g1[2], x[7] * rstd * g1[3])}; }
        }
    }
    SEAM(5);
    if (IN(6)) {
        pg8::Gemm g{ATT, W_O, MT, 1024, 1024}; pg8::StaticOrder S; S.init(MT, 1024, G, bx); EpiRes<true, false, false> E{P.in[0], P.in[1], out, XB, SSQ1};
        pg8::gemm_phase<EpiRes<true, false, false>, pg8::StaticOrder, true, true>(lds, g, S, E);
    }
    SEAM(6);
    if (IN(7)) {
        pg8::Gemm g{XB, W_MQ, MT, 512, 1024}; pg8::StaticOrder S; S.init(MT, 512, G, bx); EpiScale E{CQ, 512, SSQ1, 1.0f / 1024.0f, QS_MEM};
        pg8::gemm_phase<EpiScale, pg8::StaticOrder, true, true>(lds, g, S, E);
    }
    SEAM(7);
    if (IN(8)) {
        for (int uu = vcu; uu < 1024 + 32; uu += G) {
            AttnUnit d; d.ROPE = nullptr; d.K2 = nullptr; d.CK = nullptr; d.qpos0 = 0; d.NT = 4; d.ldq = 512; d.ldk = 512; d.ldv = 512; d.ldo = 512;
            if (uu < 1024) { const int rb = uu >> 2, h = uu & 3, b = rb >> 4; const size_t q0 = (size_t)rb * 256;
                d.nrows = 256; d.Q = CQ + q0 * 512 + h * 128; d.O = CO + q0 * 512 + h * 128; d.K = MEMK + (size_t)b * 256 * 512 + h * 128; d.V = MEMV + (size_t)b * 256 * 512 + h * 128; }
            else { const int u2 = uu - 1024, sb = u2 >> 2, h = u2 & 3; const size_t q0 = (size_t)MP + sb * 64;
                d.nrows = 64; d.Q = CQ + q0 * 512 + h * 128; d.O = CO + q0 * 512 + h * 128; d.K = MEMK + (size_t)(16 + sb) * 256 * 512 + h * 128; d.V = MEMV + (size_t)(16 + sb) * 256 * 512 + h * 128; }
            attn_unit<128, 128, 2>(d, lds);
        }
    }
    SEAM(8);
    if (IN(9)) {
        pg8::Gemm g{CO, W_MO, MT, 1024, 512}; pg8::StaticOrder S; S.init(MT, 1024, G, bx); EpiRes<true, false, true> E{nullptr, nullptr, out, XB, SSQ2};
        pg8::gemm_phase<EpiRes<true, false, true>, pg8::StaticOrder, true, true>(lds, g, S, E);
    }
    SEAM(9);
    if (IN(10)) {
        pg8::Gemm g{XB, W_GU, MT, 5632, 1024}; pg8::StaticOrder S; S.init(MT, 5632, G, bx); EpiGLU E{HB, SSQ2};
        pg8::gemm_phase<EpiGLU, pg8::StaticOrder, true, true>(lds, g, S, E);
    }
    SEAM(10);
    if (IN(11)) {
        pg8::Gemm g{HB, W_D, MT, 1024, 2816}; pg8::StaticOrder S; S.init(MT, 1024, G, bx); EpiRes<false, true, true> E{nullptr, nullptr, out, XB, SSQ3};
        pg8::gemm_phase<EpiRes<false, true, true>, pg8::StaticOrder, true, true>(lds, g, S, E);
    }
    SEAM(11);
    if (IN(12)) {
        FRESH_TID();
        for (int r0 = gw * 4; r0 < MT; r0 += NGW * 4) {
            float* y = out + (size_t)r0 * 1024; f32x4 v[16]; float rstd[4];
#pragma unroll
            for (int j = 0; j < 16; ++j) v[j] = ((const f32x4*)y)[lane + 64 * j];
#pragma unroll
            for (int k = 0; k < 4; ++k) rstd[k] = rsqrtf(SSQ3[r0 + k] * (1.0f / 1024.0f) + EPS);
#pragma unroll
            for (int j = 0; j < 16; ++j) { const f32x4 gg = ((const f32x4*)P.in[30])[lane + 64 * (j & 3)]; ((f32x4*)y)[lane + 64 * j] = v[j] * rstd[j >> 2] * gg; }
        }
    }
#undef IN
#undef SEAM
}

#ifndef N_LAUNCH_SPLIT
#define N_LAUNCH_SPLIT 0
#endif
extern "C" void kernel_launch(void* const* d_in, const int* in_sizes, int n_in, void* d_out, int out_size, void* d_ws, size_t ws_size, hipStream_t stream) {
    static int grid = 0;
    if (grid == 0) {
        if (n_in != 31 || (size_t)out_size != OUT_TOTAL || ws_size < WS_END) { fprintf(stderr, "kernel_launch: unexpected shapes: n_in %d out %d ws %zu\n", n_in, out_size, ws_size); grid = -1; return; }
        int dev = 0, cus = 0, per_cu = 0;
        hipGetDevice(&dev); hipDeviceGetAttribute(&cus, hipDeviceAttributeMultiprocessorCount, dev);
        if (hipFuncSetAttribute((const void*)fwd_kernel, hipFuncAttributeMaxDynamicSharedMemorySize, LDS_BYTES) != hipSuccess) { fprintf(stderr, "kernel_launch: hipFuncSetAttribute failed\n"); grid = -1; return; }
        if (hipOccupancyMaxActiveBlocksPerMultiprocessor(&per_cu, (const void*)fwd_kernel, NTHR, LDS_BYTES) != hipSuccess || per_cu < 1) { fprintf(stderr, "kernel_launch: occupancy query says %d\n", per_cu); per_cu = 1; }
        (void)hipGetLastError();
        grid = cus * (per_cu > 1 ? 1 : per_cu);
        fprintf(stderr, "kernel_launch: grid %d (cus %d, per_cu %d)\n", grid, cus, per_cu);
    }
    if (grid < 0) return;
    Params p{};
    for (int i = 0; i < 31; ++i) p.in[i] = (const float*)d_in[i];
    p.out = (float*)d_out; p.ws = (unsigned char*)d_ws;
#if N_LAUNCH_SPLIT
    for (int ph = 0; ph < 13; ++ph) { p.ph_lo = ph; p.ph_hi = ph + 1; hipLaunchKernelGGL(fwd_kernel, dim3(grid), dim3(NTHR), LDS_BYTES, stream, p); }
#else
#ifndef PROBE_PREFIX
#define PROBE_PREFIX 0
#endif
    if (PROBE_PREFIX > 0) {
        p.ph_lo = 0; p.ph_hi = PROBE_PREFIX;
        (void)hipMemsetAsync((char*)d_ws + WS_CTL, 0, CTL_BYTES, stream);
        void* args0[] = {&p};
        (void)hipLaunchCooperativeKernel((const void*)fwd_kernel, dim3(grid), dim3(NTHR), args0, LDS_BYTES, stream);
    }
    p.ph_lo = 0; p.ph_hi = 13;
    if (hipMemsetAsync((char*)d_ws + WS_CTL, 0, CTL_BYTES, stream) != hipSuccess) { fprintf(stderr, "kernel_launch: memset failed\n"); return; }
    void* args[] = {&p};
    hipError_t e = hipLaunchCooperativeKernel((const void*)fwd_kernel, dim3(grid), dim3(NTHR), args, LDS_BYTES, stream);
    if (e != hipSuccess) fprintf(stderr, "kernel_launch: cooperative launch failed: %s (grid %d)\n", hipGetErrorString(e), grid);
#endif
}
```
